# Optimizing an MI355X kernel written in HIP

```python
import math
import jax, jax.numpy as jnp
from jax import lax
import numpy as np

D_MODEL = 1024
BATCH = 4
SEQ = 4096
DEPTH = 1

MIX_WIDTH = D_MODEL
DIFF_HEADS = 4
DIFF_HEAD_DIM = 64
DIFF_V_DIM = 2 * DIFF_HEAD_DIM
RET_HEADS = 4
RET_QK_DIM = 64
RET_V_DIM = 2 * RET_QK_DIM
DIFF_Q_W = DIFF_HEADS * 2 * DIFF_HEAD_DIM
DIFF_V_W = DIFF_HEADS * DIFF_V_DIM
RET_QK_W = RET_HEADS * RET_QK_DIM
RET_V_W = RET_HEADS * RET_V_DIM
IN_SPLITS = (DIFF_Q_W, DIFF_Q_W, DIFF_V_W, RET_QK_W, RET_QK_W, RET_V_W, RET_V_W, D_MODEL, D_MODEL)
IN_COLS = sum(IN_SPLITS)
D_FF = ((8 * D_MODEL // 3 + 255) // 256) * 256
ROPE_THETA = 10000.0
Q_BLOCK = 128
RET_CHUNK = 128
NORM_EPS = 1e-5

kernel_name = "hybrid_diffattn_retention_gated_block"


def rmsnorm(x, g=None, eps=NORM_EPS):
    x32 = x.astype(jnp.float32)
    y = x32 * lax.rsqrt(jnp.mean(x32 * x32, axis=-1, keepdims=True) + eps)
    if g is not None:
        y = y * g.astype(jnp.float32)
    return y.astype(x.dtype)


def rope_tables(seq_len, dim):
    inv_freq = ROPE_THETA ** (-jnp.arange(0, dim, 2, dtype=jnp.float32) / dim)
    ang = jnp.arange(seq_len, dtype=jnp.float32)[:, None] * inv_freq[None, :]
    return jnp.cos(ang), jnp.sin(ang)


def apply_rope(x, cos, sin):
    half = x.shape[-1] // 2
    shp = (x.shape[1],) + (1,) * (x.ndim - 3) + (half,)
    c = cos.reshape(shp).astype(x.dtype)
    s = sin.reshape(shp).astype(x.dtype)
    x1, x2 = x[..., :half], x[..., half:]
    return jnp.concatenate([x1 * c - x2 * s, x2 * c + x1 * s], axis=-1)


def differential_attention(q, k, v, lam):
    b, s, h, _, d = q.shape
    nqb = s // Q_BLOCK
    scale = d ** -0.5
    qb = q.reshape(b, nqb, Q_BLOCK, h, 2, d).transpose(1, 0, 2, 3, 4, 5)

    def block(q_blk):
        sc = jnp.einsum('bqhcd,bkhcd->bhcqk', q_blk, k).astype(jnp.float32) * scale
        p = jax.nn.softmax(sc, axis=-1)
        a = (p[:, :, 0] - lam * p[:, :, 1]).astype(v.dtype)
        return jnp.einsum('bhqk,bkhe->bqhe', a, v)

    out = lax.map(block, qb)
    return out.transpose(1, 0, 2, 3, 4).reshape(b, s, h, v.shape[-1])


def retention_one_direction(q, k, v, log_gamma, include_diag):
    b, s, h, dk = q.shape
    dv = v.shape[-1]
    c = RET_CHUNK
    n = s // c
    dt = q.dtype
    idx = jnp.arange(c, dtype=jnp.float32)
    diff = idx[:, None] - idx[None, :]
    mask = diff >= 0 if include_diag else diff > 0
    dmat = jnp.where(mask[None], jnp.exp(jnp.where(mask, diff, 0.0)[None] * log_gamma[:, None, None]), 0.0).astype(dt)
    zeta = jnp.exp((c - 1 - idx)[:, None] * log_gamma[None, :]).astype(dt)
    xi = jnp.exp((idx + 1)[:, None] * log_gamma[None, :]).astype(dt)
    g_chunk = jnp.exp(c * log_gamma).astype(dt)

    def to_chunks(t):
        return t.reshape(b, n, c, h, t.shape[-1]).transpose(1, 0, 2, 3, 4)

    def step(state, inp):
        qc, kc, vc = inp
        sc = jnp.einsum('bihd,bjhd->bhij', qc, kc) * dmat[None]
        inner = jnp.einsum('bhij,bjhe->bihe', sc, vc)
        cross = jnp.einsum('bihd,bhde->bihe', qc, state) * xi[None, :, :, None]
        new_state = g_chunk[None, :, None, None] * state + jnp.einsum(
            'bjhd,bjhe->bhde', kc * zeta[None, :, :, None], vc)
        return new_state, inner + cross

    state0 = jnp.zeros((b, h, dk, dv), dt)
    _, ys = lax.scan(step, state0, (to_chunks(q), to_chunks(k), to_chunks(v)))
    return ys.transpose(1, 0, 2, 3, 4).reshape(b, s, h, dv)


def bidirectional_retention(q, k, v, logit_fwd, logit_bwd):
    lg_f = jax.nn.log_sigmoid(logit_fwd.astype(jnp.float32))
    lg_b = jax.nn.log_sigmoid(logit_bwd.astype(jnp.float32))
    fwd = retention_one_direction(q, k, v, lg_f, True)
    flip = lambda t: jnp.flip(t, axis=1)
    bwd = flip(retention_one_direction(flip(q), flip(k), flip(v), lg_b, False))
    return fwd + bwd


def setup_inputs(seed: int = 0) -> dict:
    key = jax.random.key(seed)
    ks = jax.random.split(key, 20)
    f32 = jnp.float32

    def nrm(k, shape, fan_in):
        return jax.random.normal(k, shape, f32) * (fan_in ** -0.5)

    def gain(k, shape):
        return 1.0 + 0.02 * jax.random.normal(k, shape, f32)

    p = jnp.exp2(-5.0 - jnp.arange(RET_HEADS, dtype=f32))
    base_logit = jnp.log1p(-p) - jnp.log(p)
    return {
        "x": jax.random.normal(ks[0], (BATCH, SEQ, D_MODEL), f32),
        "g_mix": gain(ks[1], (DEPTH, D_MODEL)),
        "w_in": nrm(ks[2], (DEPTH, D_MODEL, IN_COLS), D_MODEL),
        "diff_lq1": 0.1 * jax.random.normal(ks[3], (DEPTH, DIFF_HEAD_DIM), f32),
        "diff_lk1": 0.1 * jax.random.normal(ks[4], (DEPTH, DIFF_HEAD_DIM), f32),
        "diff_lq2": 0.1 * jax.random.normal(ks[5], (DEPTH, DIFF_HEAD_DIM), f32),
        "diff_lk2": 0.1 * jax.random.normal(ks[6], (DEPTH, DIFF_HEAD_DIM), f32),
        "diff_subln_g": gain(ks[7], (DEPTH, DIFF_V_DIM)),
        "ret_decay_fwd": base_logit[None] + 0.1 * jax.random.normal(ks[8], (DEPTH, RET_HEADS), f32),
        "ret_decay_bwd": base_logit[None] + 0.1 * jax.random.normal(ks[9], (DEPTH, RET_HEADS), f32),
        "w_up_diff": nrm(ks[10], (DEPTH, DIFF_V_W, D_MODEL), DIFF_V_W),
        "w_up_ret": nrm(ks[11], (DEPTH, RET_V_W, D_MODEL), RET_V_W),
        "w_o": nrm(ks[12], (DEPTH, D_MODEL, D_MODEL), D_MODEL),
        "g_ffn": gain(ks[13], (DEPTH, D_MODEL)),
        "w_ffn_gate": nrm(ks[14], (DEPTH, D_MODEL, D_FF), D_MODEL),
        "w_ffn_up": nrm(ks[15], (DEPTH, D_MODEL, D_FF), D_MODEL),
        "w_ffn_down": nrm(ks[16], (DEPTH, D_FF, D_MODEL), D_FF),
        "g_final": gain(ks[17], (D_MODEL,)),
    }


def reference(x, g_mix, w_in, diff_lq1, diff_lk1, diff_lq2, diff_lk2, diff_subln_g,
              ret_decay_fwd, ret_decay_bwd, w_up_diff, w_up_ret, w_o,
              g_ffn, w_ffn_gate, w_ffn_up, w_ffn_down, g_final):
    b, s, _ = x.shape
    cos, sin = rope_tables(s, DIFF_HEAD_DIM)
    split_pts = list(np.cumsum(IN_SPLITS)[:-1])
    for l in range(DEPTH):
        lam_init = 0.8 - 0.6 * math.exp(-0.3 * l)
        h = rmsnorm(x, g_mix[l])
        proj = h @ w_in[l]
        dq, dk, dv, rq, rk, rv, rg, gate_a, gate_b = jnp.split(proj, split_pts, axis=-1)

        dq = apply_rope(dq.reshape(b, s, DIFF_HEADS, 2, DIFF_HEAD_DIM), cos, sin)
        dk = apply_rope(dk.reshape(b, s, DIFF_HEADS, 2, DIFF_HEAD_DIM), cos, sin)
        dv = dv.reshape(b, s, DIFF_HEADS, DIFF_V_DIM)
        lam = (jnp.exp(jnp.sum(diff_lq1[l].astype(jnp.float32) * diff_lk1[l].astype(jnp.float32)))
               - jnp.exp(jnp.sum(diff_lq2[l].astype(jnp.float32) * diff_lk2[l].astype(jnp.float32)))
               + lam_init)
        a = differential_attention(dq, dk, dv, lam)
        a = rmsnorm(a, diff_subln_g[l]) * (1.0 - lam_init)
        ya = a.reshape(b, s, DIFF_V_W) @ w_up_diff[l]

        rq = apply_rope(rq.reshape(b, s, RET_HEADS, RET_QK_DIM), cos, sin)
        rk = apply_rope(rk.reshape(b, s, RET_HEADS, RET_QK_DIM), cos, sin) * (RET_QK_DIM ** -0.5)
        rv = rv.reshape(b, s, RET_HEADS, RET_V_DIM)
        r = bidirectional_retention(rq, rk, rv, ret_decay_fwd[l], ret_decay_bwd[l])
        r = rmsnorm(r).reshape(b, s, RET_V_W) * jax.nn.silu(rg)
        yb = r @ w_up_ret[l]

        m = jax.nn.sigmoid(gate_a) * ya + jax.nn.sigmoid(gate_b) * yb
        x = x + m @ w_o[l]

        h2 = rmsnorm(x, g_ffn[l])
        x = x + (jax.nn.silu(h2 @ w_ffn_gate[l]) * (h2 @ w_ffn_up[l])) @ w_ffn_down[l]
    return rmsnorm(x, g_final)
```

```cpp
#include <hip/hip_runtime.h>
#include <hip/hip_cooperative_groups.h>
#include <cstdio>
#include <cstdint>
namespace cg = cooperative_groups;
namespace pg8 {
#define PG8_LAS __attribute__((address_space(3)))
typedef unsigned short bf16_t;
typedef short bf16x8 __attribute__((ext_vector_type(8)));
typedef float f32x4 __attribute__((ext_vector_type(4)));
typedef unsigned u32x4 __attribute__((ext_vector_type(4)));
constexpr int BM = 256, BK = 64, HALF = 128, HTB = HALF * BK * 2  , STAGE_BYTES = 8 * HTB, NXCD = 8, WGM = 8;

__host__ __device__ __forceinline__ int lds_byte(int r, int c) { const int st = (r >> 4) * 2 + (c >> 5), rr = r & 15, cc = c & 31, ob = rr * 64 + cc * 2; return st * 1024 + (ob ^ (((ob >> 9) & 1) << 5)); }
__host__ __device__ __forceinline__ void stage_rc(int b, int& R, int& C) { const int st = b / 1024, sb = b % 1024, swz = sb ^ (((sb >> 9) & 1) << 5); R = (st >> 1) * 16 + swz / 64; C = (st & 1) * 32 + (swz % 64) / 2; }
__host__ __device__ __forceinline__ int perm32(int rho) { const int n = rho >> 4, i = rho & 15; return 8 * (i >> 2) + 4 * n + (i & 3); }

struct Unit { int pm, pn; };
struct Gemm { const bf16_t* A; const bf16_t* Bt; int M, N, K; };

struct StaticOrder {
    int nM, nN, nwg, G, c;
    __host__ __device__ void init(int M, int N, int G_, int c_) { nM = M / BM; nN = N / BM; nwg = nM * nN; G = G_; c = c_; }
    __host__ __device__ bool next(int i, Unit& u) const {
        const long L = (long)i * G + c; if (L >= nwg) return false;
        int wgid = (int)L; { const int q = nwg / NXCD, r = nwg % NXCD, xcd = wgid % NXCD, off = wgid / NXCD; wgid = (xcd < r ? xcd * (q + 1) : r * (q + 1) + (xcd - r) * q) + off; }
        const int nig = WGM * nN, gid = wgid / nig, fm = gid * WGM, gsz = (nM - fm) < WGM ? (nM - fm) : WGM;
        u.pm = fm + ((wgid % nig) % gsz); u.pn = (wgid % nig) / gsz; return true;
    }
    __device__ __forceinline__ void a_ready(const Unit&) const {}
    __device__ __forceinline__ void done(const Unit&) const {}
};

__device__ __forceinline__ unsigned cvt_pk_bf16(float lo, float hi) { typedef float f2_t __attribute__((ext_vector_type(2))); typedef __bf16 b2_t __attribute__((ext_vector_type(2))); f2_t v = {lo, hi}; b2_t b = __builtin_convertvector(v, b2_t); return __builtin_bit_cast(unsigned, b); }
template <class Epi, class Sched, bool ALIGN_EPI = false, bool SP2 = false>
__device__ __forceinline__ void gemm_phase(PG8_LAS unsigned char* lds, const Gemm g, const Sched& S, const Epi& E) {
    int tid_l = threadIdx.x; asm volatile("" : "+v"(tid_l));
    const int tid = tid_l, wid = __builtin_amdgcn_readfirstlane(tid >> 6), lane = tid & 63, wr = wid >> 2, wc = wid & 3, fr = lane & 15, fq = lane >> 4;
    const int K = g.K, nt = K / BK;
    unsigned voffA[2], voffB[2];
#pragma unroll
    for (int i = 0; i < 2; ++i) { int R, C; stage_rc(tid * 16 + i * 8192, R, C); const int Rb = Epi::PERM ? ((R & ~31) + perm32(R & 31)) : R;
        voffA[i] = (unsigned)(R * K + C) * 2u; voffB[i] = (unsigned)(Rb * K + C) * 2u; }
    const size_t kstep = (size_t)(BK * 2);
    const size_t hstep = (size_t)HALF * K * 2;
    const size_t tstep = 2 * hstep;
    const unsigned ldsw = (unsigned)wid * 1024u;
    const int aoff = lds_byte(wr * 64 + fr, fq * 8), boff = lds_byte(wc * 32 + fr, fq * 8);
#define PG8_SA(b, h) (((b) * 2 + (h)) * HTB)
#define PG8_SB(b, h) ((4 + (b) * 2 + (h)) * HTB)
#define PG8_STAGE(bufoff, gbase, voff) do { _Pragma("unroll") for (int _i = 0; _i < 2; ++_i) \
        __builtin_amdgcn_global_load_lds((const unsigned*)((const char*)(gbase) + (voff)[_i]), (PG8_LAS unsigned*)(lds + (bufoff) + ldsw + _i * 8192), 16, 0, 0); } while (0)
#define PG8_LDA(dst, b, h) do { _Pragma("unroll") for (int m = 0; m < 4; ++m) _Pragma("unroll") for (int k = 0; k < 2; ++k) dst[m][k] = *(const PG8_LAS bf16x8*)(lds + PG8_SA(b, h) + aoff + m * 2048 + k * 1024); } while (0)
#define PG8_LDB(dst, b, h) do { _Pragma("unroll") for (int n = 0; n < 2; ++n) _Pragma("unroll") for (int k = 0; k < 2; ++k) dst[n][k] = *(const PG8_LAS bf16x8*)(lds + PG8_SB(b, h) + boff + n * 2048 + k * 1024); } while (0)
#define PG8_MMA(ai, bj, At, Bt) do { __builtin_amdgcn_s_setprio(1); _Pragma("unroll") for (int m = 0; m < 4; ++m) _Pragma("unroll") for (int n = 0; n < 2; ++n) _Pragma("unroll") for (int k = 0; k < 2; ++k) \
        acc[ai][bj][m][n] = __builtin_amdgcn_mfma_f32_16x16x32_bf16(Bt[n][k], At[m][k], acc[ai][bj][m][n], 0, 0, 0); __builtin_amdgcn_s_setprio(0); } while (0)
#define PG8_WAIT_V(n) asm volatile("s_waitcnt vmcnt(" #n ")" ::: "memory")
#define PG8_WAIT_L(n) asm volatile("s_waitcnt lgkmcnt(" #n ")" ::: "memory")
#define PG8_BAR __builtin_amdgcn_s_barrier()
#define PG8_SCHED __builtin_amdgcn_sched_barrier(0)
    Unit cur, nxt; int ui = 0;
    if (!S.next(0, cur)) return;
    f32x4 acc[2][2][4][2];
#pragma unroll
    for (int a = 0; a < 2; ++a)
#pragma unroll
        for (int b = 0; b < 2; ++b)
#pragma unroll
            for (int m = 0; m < 4; ++m)
#pragma unroll
                for (int n = 0; n < 2; ++n) acc[a][b][m][n] = (f32x4){0.f, 0.f, 0.f, 0.f};
    bf16x8 At[4][2], B0[2][2], B1[2][2];
    const char* cA = (const char*)g.A + (size_t)cur.pm * tstep; const char* cB = (const char*)g.Bt + (size_t)cur.pn * tstep;
    S.a_ready(cur);
    if constexpr (SP2) {
        PG8_STAGE(PG8_SB(0, 0), cB, voffB); PG8_STAGE(PG8_SB(0, 1), cB + hstep, voffB); PG8_STAGE(PG8_SA(0, 0), cA, voffA); PG8_STAGE(PG8_SA(0, 1), cA + hstep, voffA);
        if (wr == 1) PG8_BAR;
        PG8_WAIT_V(2); PG8_BAR;
        PG8_STAGE(PG8_SB(1, 0), cB + kstep, voffB); PG8_STAGE(PG8_SA(1, 0), cA + kstep, voffA); PG8_STAGE(PG8_SB(1, 1), cB + hstep + kstep, voffB);
        PG8_WAIT_V(6); PG8_BAR;
    } else {
        PG8_STAGE(PG8_SB(0, 0), cB, voffB); PG8_STAGE(PG8_SA(0, 0), cA, voffA); PG8_STAGE(PG8_SB(0, 1), cB + hstep, voffB); PG8_STAGE(PG8_SA(0, 1), cA + hstep, voffA);
        if (wr == 1) PG8_BAR;
        PG8_WAIT_V(4); PG8_BAR;
        PG8_STAGE(PG8_SB(1, 0), cB + kstep, voffB); PG8_STAGE(PG8_SA(1, 0), cA + kstep, voffA); PG8_STAGE(PG8_SB(1, 1), cB + hstep + kstep, voffB);
        PG8_WAIT_V(6); PG8_BAR;
    }
    for (;;) {
        const bool has_next = S.next(ui + 1, nxt);
        const char* nA = has_next ? (const char*)g.A + (size_t)nxt.pm * tstep : cA; const char* nB = has_next ? (const char*)g.Bt + (size_t)nxt.pn * tstep : cB;
        for (int t = 0; t < nt; t += 2) {
            const bool last = (t == nt - 2);
            const char* a1 = cA + (size_t)(t + 1) * kstep;
            const char* a2 = last ? nA : cA + (size_t)(t + 2) * kstep; const char* b2 = last ? nB : cB + (size_t)(t + 2) * kstep;
            const char* a3 = a2 + kstep; const char* b3 = b2 + kstep;
            if (last && has_next) S.a_ready(nxt);
            if constexpr (SP2) {
            PG8_LDB(B0, 0, 0); PG8_LDB(B1, 0, 1); PG8_SCHED; PG8_LDA(At, 0, 0); PG8_STAGE(PG8_SA(1, 1), a1 + hstep, voffA);
            PG8_WAIT_V(8); PG8_WAIT_L(0); PG8_BAR; PG8_MMA(0, 0, At, B0); PG8_MMA(0, 1, At, B1); PG8_BAR; PG8_SCHED;
            PG8_LDA(At, 0, 1); PG8_STAGE(PG8_SB(0, 0), b2, voffB); PG8_STAGE(PG8_SB(0, 1), b2 + hstep, voffB); PG8_STAGE(PG8_SA(0, 0), a2, voffA);
            PG8_WAIT_V(8); PG8_WAIT_L(0); PG8_BAR; PG8_MMA(1, 0, At, B0); PG8_MMA(1, 1, At, B1); PG8_BAR; PG8_SCHED;
            PG8_LDB(B0, 1, 0); PG8_LDB(B1, 1, 1); PG8_SCHED; PG8_LDA(At, 1, 0); PG8_STAGE(PG8_SA(0, 1), a2 + hstep, voffA);
            PG8_WAIT_V(8); PG8_WAIT_L(0); PG8_BAR; PG8_MMA(0, 0, At, B0); PG8_MMA(0, 1, At, B1); PG8_BAR; PG8_SCHED;
            PG8_LDA(At, 1, 1); PG8_STAGE(PG8_SB(1, 0), b3, voffB); PG8_STAGE(PG8_SB(1, 1), b3 + hstep, voffB); PG8_STAGE(PG8_SA(1, 0), a3, voffA);
            PG8_WAIT_V(8); PG8_WAIT_L(0); PG8_BAR; PG8_MMA(1, 0, At, B0); PG8_MMA(1, 1, At, B1); PG8_BAR; PG8_SCHED;
            } else {
            PG8_LDB(B0, 0, 0); PG8_SCHED; PG8_LDA(At, 0, 0); PG8_STAGE(PG8_SA(1, 1), a1 + hstep, voffA);
            PG8_WAIT_L(8); PG8_BAR; PG8_WAIT_L(0); PG8_MMA(0, 0, At, B0); PG8_BAR; PG8_SCHED;
            PG8_LDB(B1, 0, 1); PG8_STAGE(PG8_SB(0, 0), b2, voffB);
            PG8_BAR; PG8_WAIT_L(0); PG8_MMA(0, 1, At, B1); PG8_BAR;
            PG8_LDA(At, 0, 1); PG8_STAGE(PG8_SA(0, 0), a2, voffA);
            PG8_BAR; PG8_WAIT_L(0); PG8_MMA(1, 0, At, B0); PG8_BAR; PG8_SCHED;
            PG8_STAGE(PG8_SB(0, 1), b2 + hstep, voffB);
            PG8_WAIT_V(6); PG8_BAR; PG8_MMA(1, 1, At, B1); PG8_BAR;
            PG8_LDB(B0, 1, 0); PG8_SCHED; PG8_LDA(At, 1, 0); PG8_STAGE(PG8_SA(0, 1), a2 + hstep, voffA);
            PG8_WAIT_L(8); PG8_BAR; PG8_WAIT_L(0); PG8_MMA(0, 0, At, B0); PG8_BAR; PG8_SCHED;
            PG8_LDB(B1, 1, 1); PG8_STAGE(PG8_SB(1, 0), b3, voffB);
            PG8_BAR; PG8_WAIT_L(0); PG8_MMA(0, 1, At, B1); PG8_BAR;
            PG8_LDA(At, 1, 1); PG8_STAGE(PG8_SA(1, 0), a3, voffA);
            PG8_BAR; PG8_WAIT_L(0); PG8_MMA(1, 0, At, B0); PG8_BAR; PG8_SCHED;
            PG8_STAGE(PG8_SB(1, 1), b3 + hstep, voffB);
            PG8_WAIT_V(6); PG8_BAR; PG8_MMA(1, 1, At, B1); PG8_BAR;
            }
        }
        if constexpr (ALIGN_EPI) { if (wr == 0) PG8_BAR; }
        if constexpr (!Epi::AFTER_DRAIN) { E(acc, cur, wr, wc, fr, fq); S.done(cur); }
        if (!has_next) break;
#pragma unroll
        for (int a = 0; a < 2; ++a)
#pragma unroll
            for (int b = 0; b < 2; ++b)
#pragma unroll
                for (int m = 0; m < 4; ++m)
#pragma unroll
                    for (int n = 0; n < 2; ++n) acc[a][b][m][n] = (f32x4){0.f, 0.f, 0.f, 0.f};
        cur = nxt; cA = nA; cB = nB; ++ui;
        if constexpr (ALIGN_EPI) { if (wr == 1) PG8_BAR; }
    }
    PG8_WAIT_V(0);
    if constexpr (!ALIGN_EPI) { if (wr == 0) PG8_BAR; }
    PG8_BAR;
    if constexpr (Epi::AFTER_DRAIN) { E.fused(acc, cur, wr, wc, fr, fq, lds, wid, lane); S.done(cur); }
#undef PG8_SA
#undef PG8_SB
#undef PG8_STAGE
#undef PG8_LDA
#undef PG8_LDB
#undef PG8_MMA
#undef PG8_WAIT_V
#undef PG8_WAIT_L
#undef PG8_BAR
#undef PG8_SCHED
}
}

constexpr int BATCH = 4, SEQ = 4096, DM = 1024, M = BATCH * SEQ;
constexpr int NQKV = 3072, NGATE = 2048, NIN = 5120, DFF = 2816, NGU = 2 * DFF;
constexpr float NORM_EPS = 1e-5f;
constexpr int NTHREADS = 512;

typedef unsigned short bf16_t;
typedef short bf16x8 __attribute__((ext_vector_type(8)));
typedef short s16x4 __attribute__((ext_vector_type(4)));
typedef float f32x4 __attribute__((ext_vector_type(4)));
typedef float f32x16 __attribute__((ext_vector_type(16)));
typedef unsigned u32x4 __attribute__((ext_vector_type(4)));
#define LAS __attribute__((address_space(3)))
#define SBAR() __builtin_amdgcn_sched_barrier(0)
#define LDS_WAIT() asm volatile("s_waitcnt lgkmcnt(0)" ::: "memory")

constexpr size_t MiB = 1u << 20;
constexpr size_t WS_CTL = 0, CTL_BYTES = 1 * MiB;
constexpr size_t WS_ROPE = 1 * MiB;
constexpr size_t WS_WIN = 2 * MiB;
constexpr size_t WS_WUP = 12 * MiB;
constexpr size_t WS_WO = 14 * MiB;
constexpr size_t WS_WGU = 16 * MiB;
constexpr size_t WS_WD = 27 * MiB;
constexpr size_t WS_SST = 33 * MiB;
constexpr size_t WS_H = 49 * MiB;
constexpr size_t WS_QKV = 81 * MiB;
constexpr size_t WS_GATES = 177 * MiB;
constexpr size_t WS_END = 241 * MiB;

constexpr int LDS_BYTES = 131072;

__device__ __forceinline__ float bf2f(unsigned v) { return __uint_as_float(v << 16); }
__device__ __forceinline__ bf16_t f2bf(float f) { unsigned u = __float_as_uint(f); return (bf16_t)((u + 0x7fffu + ((u >> 16) & 1u)) >> 16); }
__device__ __forceinline__ unsigned pk2(float lo, float hi) { return pg8::cvt_pk_bf16(lo, hi); }
__device__ __forceinline__ bf16x8 scale8(bf16x8 v, float z) {
    u32x4 w = __builtin_bit_cast(u32x4, v), o;
#pragma unroll
    for (int i = 0; i < 4; ++i) { const float lo = __uint_as_float(w[i] << 16), hi = __uint_as_float(w[i] & 0xffff0000u); o[i] = pk2(lo * z, hi * z); }
    return __builtin_bit_cast(bf16x8, o);
}
__device__ __forceinline__ float wave_sum(float v) {
#pragma unroll
    for (int o = 1; o < 64; o <<= 1) v += __shfl_xor(v, o);
    return v;
}
__device__ __forceinline__ float log2_sigmoid(float x) {
    const float sp = fmaxf(-x, 0.f) + log1pf(__expf(-fabsf(x)));
    return -sp * 1.4426950408889634f;
}
__device__ __forceinline__ int crow(int r, int hi) { return (r & 3) + 8 * (r >> 2) + 4 * hi; }

using pg8::Unit;
struct EpiProj {
    static constexpr bool PERM = true, AFTER_DRAIN = false;
    bf16_t* QKV; bf16_t* GATES; const float* cosT; const float* sinT;
    __device__ __forceinline__ void operator()(const f32x4 (&acc)[2][2][4][2], const Unit& u, int wr, int wc, int fr_, int fq_) const {
        int fr = fr_, fq = fq_; asm volatile("" : "+v"(fr), "+v"(fq));
        const int pn = u.pn, row0 = u.pm * 256 + wr * 64 + fr, cl = wc * 32 + 8 * fq;
        if (pn < 12) {
            const bool rope = (pn < 4) || pn == 6 || pn == 7;
            const float rsc = (pn == 7) ? 0.125f : 1.f;
            const int i0 = (cl & 63) >> 1;
#pragma unroll
            for (int ai = 0; ai < 2; ++ai)
#pragma unroll
                for (int m = 0; m < 4; ++m) {
                    const int row = row0 + ai * 128 + m * 16;
                    f32x4 cs = {1.f, 1.f, 1.f, 1.f}, sn = {0.f, 0.f, 0.f, 0.f};
                    if (rope) { const int pos = row & (SEQ - 1); cs = *(const f32x4*)(cosT + pos * 32 + i0); sn = *(const f32x4*)(sinT + pos * 32 + i0); }
                    bf16_t* rowp = QKV + (size_t)row * NQKV + 256 * pn + cl;
#pragma unroll
                    for (int bj = 0; bj < 2; ++bj) {
                        const f32x4 v0 = acc[ai][bj][m][0], v1 = acc[ai][bj][m][1];
                        u32x4 w;
                        w.x = pk2((v0[0] * cs[0] - v0[1] * sn[0]) * rsc, (v0[1] * cs[0] + v0[0] * sn[0]) * rsc);
                        w.y = pk2((v0[2] * cs[1] - v0[3] * sn[1]) * rsc, (v0[3] * cs[1] + v0[2] * sn[1]) * rsc);
                        w.z = pk2((v1[0] * cs[2] - v1[1] * sn[2]) * rsc, (v1[1] * cs[2] + v1[0] * sn[2]) * rsc);
                        w.w = pk2((v1[2] * cs[3] - v1[3] * sn[3]) * rsc, (v1[3] * cs[3] + v1[2] * sn[3]) * rsc);
                        *(u32x4*)(rowp + bj * 128) = w;
                    }
                }
        } else {
#pragma unroll
            for (int ai = 0; ai < 2; ++ai)
#pragma unroll
                for (int m = 0; m < 4; ++m) {
                    const int row = row0 + ai * 128 + m * 16;
                    bf16_t* rowp = GATES + (size_t)row * NGATE + 256 * (pn - 12) + cl;
#pragma unroll
                    for (int bj = 0; bj < 2; ++bj) {
                        f32x4 v0 = acc[ai][bj][m][0], v1 = acc[ai][bj][m][1];
#pragma unroll
                        for (int i = 0; i < 4; ++i) { v0[i] = __builtin_amdgcn_rcpf(1.f + __expf(-v0[i])); v1[i] = __builtin_amdgcn_rcpf(1.f + __expf(-v1[i])); }
                        u32x4 w; w.x = pk2(v0[0], v0[1]); w.y = pk2(v0[2], v0[3]); w.z = pk2(v1[0], v1[1]); w.w = pk2(v1[2], v1[3]);
                        *(u32x4*)(rowp + bj * 128) = w;
                    }
                }
        }
    }
};
struct EpiUp {
    static constexpr bool PERM = true, AFTER_DRAIN = false;
    const bf16_t* GATES; bf16_t* Mb;
    __device__ __forceinline__ void operator()(const f32x4 (&acc)[2][2][4][2], const Unit& u, int wr, int wc, int fr_, int fq_) const {
        int fr = fr_, fq = fq_; asm volatile("" : "+v"(fr), "+v"(fq));
        const int which = u.pm >> 6, pm = u.pm & 63, pn = u.pn & 3;
        const int row0 = pm * 256 + wr * 64 + fr, col0 = pn * 256 + wc * 32 + 8 * fq;
#pragma unroll
        for (int ai = 0; ai < 2; ++ai)
#pragma unroll
            for (int m = 0; m < 4; ++m) {
                const int row = row0 + ai * 128 + m * 16;
#pragma unroll
                for (int bj = 0; bj < 2; ++bj) {
                    const int col = col0 + bj * 128;
                    const u32x4 g = *(const u32x4*)(GATES + (size_t)row * NGATE + which * 1024 + col);
                    const f32x4 v0 = acc[ai][bj][m][0], v1 = acc[ai][bj][m][1];
                    float o[8];
                    o[0] = v0[0] * bf2f(g.x & 0xffffu); o[1] = v0[1] * bf2f(g.x >> 16); o[2] = v0[2] * bf2f(g.y & 0xffffu); o[3] = v0[3] * bf2f(g.y >> 16);
                    o[4] = v1[0] * bf2f(g.z & 0xffffu); o[5] = v1[1] * bf2f(g.z >> 16); o[6] = v1[2] * bf2f(g.w & 0xffffu); o[7] = v1[3] * bf2f(g.w >> 16);
                    bf16_t* dst = Mb + (size_t)row * DM + col;
                    if (which) { const u32x4 p = *(const u32x4*)dst;
                        o[0] += bf2f(p.x & 0xffffu); o[1] += bf2f(p.x >> 16); o[2] += bf2f(p.y & 0xffffu); o[3] += bf2f(p.y >> 16);
                        o[4] += bf2f(p.z & 0xffffu); o[5] += bf2f(p.z >> 16); o[6] += bf2f(p.w & 0xffffu); o[7] += bf2f(p.w >> 16); }
                    u32x4 w; w.x = pk2(o[0], o[1]); w.y = pk2(o[2], o[3]); w.z = pk2(o[4], o[5]); w.w = pk2(o[6], o[7]);
                    *(u32x4*)dst = w;
                }
            }
    }
};
struct EpiRes {
    static constexpr bool PERM = true, AFTER_DRAIN = false;
    const float* xin; float* xout; bf16_t* xb; float* rowsq;
    __device__ __forceinline__ void operator()(const f32x4 (&acc)[2][2][4][2], const Unit& u, int wr, int wc, int fr_, int fq_) const {
        int fr = fr_, fq = fq_; asm volatile("" : "+v"(fr), "+v"(fq));
        const int row0 = u.pm * 256 + wr * 64 + fr, col0 = u.pn * 256 + wc * 32 + 8 * fq;
#pragma unroll
        for (int ai = 0; ai < 2; ++ai)
#pragma unroll
            for (int m = 0; m < 4; ++m) {
                const int row = row0 + ai * 128 + m * 16; float ss = 0.f;
#pragma unroll
                for (int bj = 0; bj < 2; ++bj) {
                    const size_t off = (size_t)row * DM + col0 + bj * 128;
                    const f32x4 a0 = *(const f32x4*)(xin + off), a1 = *(const f32x4*)(xin + off + 4);
                    const f32x4 v0 = acc[ai][bj][m][0] + a0, v1 = acc[ai][bj][m][1] + a1;
                    *(f32x4*)(xout + off) = v0; *(f32x4*)(xout + off + 4) = v1;
                    ss += (v0[0] * v0[0] + v0[1] * v0[1]) + (v0[2] * v0[2] + v0[3] * v0[3]) + (v1[0] * v1[0] + v1[1] * v1[1]) + (v1[2] * v1[2] + v1[3] * v1[3]);
                    if (xb) { u32x4 w; w.x = pk2(v0[0], v0[1]); w.y = pk2(v0[2], v0[3]); w.z = pk2(v1[0], v1[1]); w.w = pk2(v1[2], v1[3]); *(u32x4*)(xb + off) = w; }
                }
                ss += __shfl_xor(ss, 16); ss += __shfl_xor(ss, 32);
                if (fq == 0) atomicAdd(rowsq + row, ss);
            }
    }
};
struct EpiSwiGLU {
    static constexpr bool PERM = true, AFTER_DRAIN = false;
    const float* rowsq; bf16_t* HM;
    __device__ __forceinline__ void operator()(const f32x4 (&acc)[2][2][4][2], const Unit& u, int wr, int wc, int fr_, int fq_) const {
        int fr = fr_, fq = fq_; asm volatile("" : "+v"(fr), "+v"(fq));
        const int row0 = u.pm * 256 + wr * 64 + fr, col0 = u.pn * 128 + wc * 32 + 8 * fq;
#pragma unroll
        for (int ai = 0; ai < 2; ++ai)
#pragma unroll
            for (int m = 0; m < 4; ++m) {
                const int row = row0 + ai * 128 + m * 16;
                const float rstd = __builtin_amdgcn_rsqf(rowsq[row] * (1.f / DM) + NORM_EPS);
                const f32x4 g0 = acc[ai][0][m][0] * rstd, g1 = acc[ai][0][m][1] * rstd, u0 = acc[ai][1][m][0] * rstd, u1 = acc[ai][1][m][1] * rstd;
                float o[8];
#pragma unroll
                for (int i = 0; i < 4; ++i) { o[i] = g0[i] * __builtin_amdgcn_rcpf(1.f + __expf(-g0[i])) * u0[i]; o[4 + i] = g1[i] * __builtin_amdgcn_rcpf(1.f + __expf(-g1[i])) * u1[i]; }
                u32x4 w; w.x = pk2(o[0], o[1]); w.y = pk2(o[2], o[3]); w.z = pk2(o[4], o[5]); w.w = pk2(o[6], o[7]);
                *(u32x4*)(HM + (size_t)row * DFF + col0) = w;
            }
    }
};
struct PairOrder {
    pg8::StaticOrder base;
    __device__ void init(int G, int c) { base.init(M, DM, G, c); }
    __device__ bool next(int i, Unit& u) const { Unit t; if (!base.next(i >> 1, t)) return false; const int w = i & 1; u.pm = t.pm + 64 * w; u.pn = t.pn + 4 * w; return true; }
    __device__ __forceinline__ void a_ready(const Unit&) const {}
    __device__ __forceinline__ void done(const Unit&) const {}
};

__device__ __forceinline__ int v_st(int k, int c) { const int kk = (k & ~0xC) | ((k & 4) << 1) | ((k & 8) >> 1); return ((kk >> 3) * 4 + (c >> 5)) * 512 + ((kk & 7) * 32 + (c & 31)) * 2; }
__device__ __forceinline__ int v_rd_base(int lane) { return ((lane & 3) << 3) | (((lane >> 2) & 3) << 6) | (((lane >> 4) & 1) << 5) | (((lane >> 5) & 1) << 8); }
__host__ __device__ constexpr int v_rd_off(int d0, int ks, int half) { return d0 * 512 + ks * 4096 + half * 2048; }
template <int OFF> __device__ __forceinline__ s16x4 tr_read(int vb) { s16x4 r; asm volatile("ds_read_b64_tr_b16 %0, %1 offset:%2" : "=&v"(r) : "v"(vb), "i"(OFF) : "memory"); return r; }
#define PKLH(L, H) (bf16x8){L[0], L[1], L[2], L[3], H[0], H[1], H[2], H[3]}
#define MFMA32(a, b, c) __builtin_amdgcn_mfma_f32_32x32x16_bf16((a), (b), (c), 0, 0, 0)
#define PK4(P, BASE, OUT) do { unsigned a0_ = pk2(P[BASE + 0], P[BASE + 1]), a1_ = pk2(P[BASE + 2], P[BASE + 3]);   \
    unsigned b0_ = pk2(P[BASE + 4], P[BASE + 5]), b1_ = pk2(P[BASE + 6], P[BASE + 7]);                              \
    auto r0_ = __builtin_amdgcn_permlane32_swap(a0_, b0_, false, false); auto r1_ = __builtin_amdgcn_permlane32_swap(a1_, b1_, false, false); \
    u32x4 w_ = {r0_[0], r1_[0], r0_[1], r1_[1]}; OUT = __builtin_bit_cast(bf16x8, w_); } while (0)

namespace att {
constexpr float SCALE = 0.125f, THR = 8.f;
constexpr int SHM_V = 64 * 128 * 2, SHM_K = SHM_V, SDEPTH = 1;
#define KSWZ(row, colB) ((row) * 256 + ((colB) ^ (((row) & 7) << 4)))
__device__ __forceinline__ void partialSM(f32x16& p0, f32x16& p1, float& m_reg, float& mn, float& alpha) {
    constexpr float C = SCALE * 1.4426950408889634f;
    float pmax = p0[0];
#pragma unroll
    for (int r = 1; r < 16; ++r) pmax = fmaxf(pmax, p0[r]);
#pragma unroll
    for (int r = 0; r < 16; ++r) pmax = fmaxf(pmax, p1[r]);
    { auto rr = __builtin_amdgcn_permlane32_swap(__float_as_uint(pmax), __float_as_uint(pmax), false, false); pmax = fmaxf(__uint_as_float(rr[0]), __uint_as_float(rr[1])); }
    if (__builtin_expect(__all(pmax - m_reg <= THR / SCALE), 1)) { mn = m_reg; alpha = 1.f; }
    else { mn = fmaxf(m_reg, pmax); alpha = __builtin_amdgcn_exp2f((m_reg - mn) * C); m_reg = mn; }
    const float mnC = -mn * C;
#pragma unroll
    for (int r = 0; r < 16; ++r) p0[r] = fmaf(p0[r], C, mnC);
#pragma unroll
    for (int r = 0; r < 16; ++r) p1[r] = fmaf(p1[r], C, mnC);
#pragma unroll
    for (int r = 0; r < 16; ++r) p0[r] = __builtin_amdgcn_exp2f(p0[r]);
}
__device__ __forceinline__ void finishSM(f32x16& p0, f32x16& p1, float alpha, float& l_reg, bf16x8& pa0, bf16x8& pa1, bf16x8& pa2, bf16x8& pa3) {
#pragma unroll
    for (int r = 0; r < 16; ++r) p1[r] = __builtin_amdgcn_exp2f(p1[r]);
    float ps = 0.f;
#pragma unroll
    for (int r = 0; r < 16; ++r) ps += p0[r];
#pragma unroll
    for (int r = 0; r < 16; ++r) ps += p1[r];
    { auto rr = __builtin_amdgcn_permlane32_swap(__float_as_uint(ps), __float_as_uint(ps), false, false); ps = __uint_as_float(rr[0]) + __uint_as_float(rr[1]); }
    l_reg = l_reg * alpha + ps;
    PK4(p0, 0, pa0); PK4(p0, 8, pa1); PK4(p1, 0, pa2); PK4(p1, 8, pa3);
}
__device__ __forceinline__ void qkt(f32x16& p0, f32x16& p1, const char* Ks, const bf16x8* qr, int r32, int hi, int comp) {
    p0 = f32x16{}; p1 = f32x16{};
#pragma unroll
    for (int d0 = 0; d0 < 4; ++d0) { const int cb = (comp * 64 + d0 * 16 + hi * 8) * 2;
        const bf16x8 b0 = *(const bf16x8*)(Ks + KSWZ(r32, cb));
        const bf16x8 b1 = *(const bf16x8*)(Ks + KSWZ(32 + r32, cb));
        p0 = MFMA32(b0, qr[d0], p0); p1 = MFMA32(b1, qr[d0], p1); }
}
template <int D0> __device__ __forceinline__ void pv_one(f32x16& od, int vb, bf16x8 pa0, bf16x8 pa1, bf16x8 pa2, bf16x8 pa3) {
    const s16x4 l0 = tr_read<v_rd_off(D0, 0, 0)>(vb), h0 = tr_read<v_rd_off(D0, 0, 1)>(vb), l1 = tr_read<v_rd_off(D0, 1, 0)>(vb), h1 = tr_read<v_rd_off(D0, 1, 1)>(vb);
    const s16x4 l2 = tr_read<v_rd_off(D0, 2, 0)>(vb), h2 = tr_read<v_rd_off(D0, 2, 1)>(vb), l3 = tr_read<v_rd_off(D0, 3, 0)>(vb), h3 = tr_read<v_rd_off(D0, 3, 1)>(vb);
    LDS_WAIT(); SBAR();
    od = MFMA32(pa0, PKLH(l0, h0), od); od = MFMA32(pa1, PKLH(l1, h1), od); od = MFMA32(pa2, PKLH(l2, h2), od); od = MFMA32(pa3, PKLH(l3, h3), od);
}
__device__ __forceinline__ void pv_d0(f32x16* o, int vb, bf16x8 pa0, bf16x8 pa1, bf16x8 pa2, bf16x8 pa3) {
    pv_one<0>(o[0], vb, pa0, pa1, pa2, pa3); pv_one<1>(o[1], vb, pa0, pa1, pa2, pa3); pv_one<2>(o[2], vb, pa0, pa1, pa2, pa3); pv_one<3>(o[3], vb, pa0, pa1, pa2, pa3);
}
__device__ __forceinline__ void attn_unit(int b, int h, int qb, const bf16_t* __restrict__ QKV, bf16_t* __restrict__ AR, const float* __restrict__ subg, float lam, char* lds) {
    const int tid = threadIdx.x, wid = tid >> 6, lane = tid & 63, r32 = lane & 31, hi = lane >> 5;
    const int rb = wid >> 1, comp = wid & 1;
    char* V_lds = lds; char* K_lds = lds + 2 * SHM_V;
    float* ws = (float*)(lds + 2 * SHM_V + 2 * SHM_K) + wid * 64; float* li_l = ws; float* al_l = ws + 32;
    const long rowbase = (long)b * SEQ; const int q0 = qb * 128;
    float m_reg = -1e30f, l_reg = 0.f; f32x16 o[4] = {}; bf16x8 qr[4];
    { const bf16_t* Qw = QKV + (rowbase + q0 + rb * 32 + r32) * NQKV + h * 128 + comp * 64 + hi * 8;
#pragma unroll
      for (int d0 = 0; d0 < 4; ++d0) qr[d0] = *(const bf16x8*)(Qw + d0 * 16); }
    const bf16_t* Kh = QKV + rowbase * NQKV + 512 + h * 128; const bf16_t* Vh = QKV + rowbase * NQKV + 1024 + h * 128;
    const int sr = tid >> 4, sc = (tid & 15) * 8, vst0 = v_st(sr, sc), vst1 = v_st(32 + sr, sc);
    const int vb0 = (int)(uintptr_t)V_lds + v_rd_base(lane);
    struct { bf16x8 vs0, vs1, ks0, ks1; } sr_[SDEPTH];
#define SLOAD(i, k0) do { sr_[i].vs0 = *(const bf16x8*)(Vh + (long)((k0) + sr) * NQKV + sc); sr_[i].vs1 = *(const bf16x8*)(Vh + (long)((k0) + 32 + sr) * NQKV + sc); \
    sr_[i].ks0 = *(const bf16x8*)(Kh + (long)((k0) + sr) * NQKV + sc); sr_[i].ks1 = *(const bf16x8*)(Kh + (long)((k0) + 32 + sr) * NQKV + sc); } while (0)
#define SWRITE(bb, i) do { *(bf16x8*)(V_lds + (bb) * SHM_V + vst0) = sr_[i].vs0; *(bf16x8*)(V_lds + (bb) * SHM_V + vst1) = sr_[i].vs1; \
    *(bf16x8*)(K_lds + (bb) * SHM_K + KSWZ(sr, sc * 2)) = sr_[i].ks0; *(bf16x8*)(K_lds + (bb) * SHM_K + KSWZ(32 + sr, sc * 2)) = sr_[i].ks1; } while (0)
#define SWAIT() asm volatile("s_waitcnt vmcnt(0)" ::: "memory")
#define RESC(a) do { if (__any((a) < 1.f)) { if (hi == 0) al_l[r32] = (a); LDS_WAIT(); \
    _Pragma("unroll") for (int d = 0; d < 4; ++d) _Pragma("unroll") for (int r = 0; r < 16; ++r) o[d][r] *= al_l[crow(r, hi)]; } } while (0)
    f32x16 pA0, pA1, pB0, pB1; float mnA, mnB, alA, alB; bf16x8 pa0, pa1, pa2, pa3; constexpr int NT = SEQ / 64;
    constexpr int SE = 0, SO = SDEPTH - 1;
    SLOAD(SE, 0); asm volatile("s_waitcnt vmcnt(0)" ::: "memory"); SWRITE(0, SE); __syncthreads();
    qkt(pA0, pA1, K_lds, qr, r32, hi, comp); partialSM(pA0, pA1, m_reg, mnA, alA);
    SLOAD(SO, 64);
    SWAIT(); SWRITE(1, SO); __syncthreads();
    for (int j = 1; j + 1 < NT; j += 2) {
        SBAR(); qkt(pB0, pB1, K_lds + SHM_K, qr, r32, hi, comp);
        finishSM(pA0, pA1, alA, l_reg, pa0, pa1, pa2, pa3); SBAR();
        SLOAD(SO, (j + SDEPTH) * 64); SBAR();
        pv_d0(o, vb0, pa0, pa1, pa2, pa3); partialSM(pB0, pB1, m_reg, mnB, alB);
        __syncthreads(); SWAIT(); SWRITE(0, SE);
        RESC(alB); __syncthreads();
        SBAR(); qkt(pA0, pA1, K_lds, qr, r32, hi, comp);
        finishSM(pB0, pB1, alB, l_reg, pa0, pa1, pa2, pa3); SBAR();
        SLOAD(SE, (j + 1 + SDEPTH) * 64);
        SBAR();
        pv_d0(o, vb0 + SHM_V, pa0, pa1, pa2, pa3); partialSM(pA0, pA1, m_reg, mnA, alA);
        __syncthreads(); SWAIT(); SWRITE(1, SO);
        RESC(alA); __syncthreads();
    }
    SBAR(); qkt(pB0, pB1, K_lds + SHM_K, qr, r32, hi, comp);
    finishSM(pA0, pA1, alA, l_reg, pa0, pa1, pa2, pa3); SBAR();
    pv_d0(o, vb0, pa0, pa1, pa2, pa3); partialSM(pB0, pB1, m_reg, mnB, alB);
    __syncthreads(); RESC(alB);
    finishSM(pB0, pB1, alB, l_reg, pa0, pa1, pa2, pa3); SBAR();
    pv_d0(o, vb0 + SHM_V, pa0, pa1, pa2, pa3);
#undef SLOAD
#undef SWRITE
#undef SWAIT
#undef RESC
    if (hi == 0) li_l[r32] = (comp ? lam : 1.f) / l_reg;
    LDS_WAIT();
    float rli[16];
#pragma unroll
    for (int r = 0; r < 16; ++r) rli[r] = li_l[crow(r, hi)];
    __syncthreads();
    float* X = (float*)lds + rb * (32 * 128);
    if (comp) {
#pragma unroll
        for (int r = 0; r < 16; ++r)
#pragma unroll
            for (int d = 0; d < 4; ++d) X[crow(r, hi) * 128 + d * 32 + r32] = o[d][r] * rli[r];
    }
    __syncthreads();
    if (!comp) {
        float ssq[16];
#pragma unroll
        for (int r = 0; r < 16; ++r) { float s = 0.f;
#pragma unroll
            for (int d = 0; d < 4; ++d) { const float v = o[d][r] * rli[r] - X[crow(r, hi) * 128 + d * 32 + r32]; o[d][r] = v; s += v * v; }
            ssq[r] = s; }
#pragma unroll
        for (int off = 1; off < 32; off <<= 1)
#pragma unroll
            for (int r = 0; r < 16; ++r) ssq[r] += __shfl_xor(ssq[r], off);
        float gg[4];
#pragma unroll
        for (int d = 0; d < 4; ++d) gg[d] = subg[d * 32 + r32] * 0.8f;
#pragma unroll
        for (int r = 0; r < 16; ++r) { const float rs = __builtin_amdgcn_rsqf(ssq[r] * (1.f / 128.f) + NORM_EPS);
            bf16_t* orow = AR + (size_t)(rowbase + q0 + rb * 32 + crow(r, hi)) * 512 + h * 128 + r32;
#pragma unroll
            for (int d = 0; d < 4; ++d) orow[d * 32] = f2bf(o[d][r] * rs * gg[d]); }
    }
    LDS_WAIT();
    __syncthreads();
}
}

namespace ret {
template <int DUMMY> __device__ __forceinline__ s16x4 tr_rt(int addr) { s16x4 r; asm volatile("ds_read_b64_tr_b16 %0, %1" : "=&v"(r) : "v"(addr) : "memory"); return r; }
__device__ __forceinline__ void r1_unit(int unit, const bf16_t* __restrict__ QKV, float* __restrict__ U, const float* dec_f, const float* dec_b, char* lds) {
    const int tid = threadIdx.x, wid = tid >> 6, lane = tid & 63, r32 = lane & 31, hi = lane >> 5;
    const int bh = unit >> 5, c = unit & 31, b = bh >> 2, h = bh & 3;
    const long rowbase = (long)b * SEQ + c * 128;
    const float lgf = log2_sigmoid(dec_f[h]), lgb = log2_sigmoid(dec_b[h]);
#pragma unroll
    for (int i = 0; i < 2; ++i) { const int q = tid + 512 * i, key = q >> 3, cc = (q & 7) * 8;
        const bf16x8 v = *(const bf16x8*)(QKV + (rowbase + key) * NQKV + 1792 + h * 64 + cc);
        *(bf16x8*)(lds + (key >> 6) * 16384 + v_st(key & 63, cc)) = v; }
#pragma unroll
    for (int i = 0; i < 4; ++i) { const int q = tid + 512 * i, key = q >> 4, cc = (q & 15) * 8;
        const bf16x8 v = *(const bf16x8*)(QKV + (rowbase + key) * NQKV + 2048 + h * 128 + cc);
        const float zf = __builtin_amdgcn_exp2f((float)(127 - key) * lgf), zb = __builtin_amdgcn_exp2f((float)key * lgb);
        *(bf16x8*)(lds + 32768 + (key >> 6) * 16384 + v_st(key & 63, cc)) = scale8(v, zf);
        *(bf16x8*)(lds + 65536 + (key >> 6) * 16384 + v_st(key & 63, cc)) = scale8(v, zb); }
    __syncthreads();
    const int dir = wid >> 2, eb = wid & 3;
    const int base = (int)(uintptr_t)lds + v_rd_base(lane);
    f32x16 acc0 = {}, acc1 = {};
#pragma unroll
    for (int img = 0; img < 2; ++img)
#pragma unroll
        for (int ks = 0; ks < 4; ++ks) {
            const int va = base + 32768 + dir * 32768 + img * 16384 + eb * 512 + ks * 4096;
            const int ka = base + img * 16384 + ks * 4096;
            const s16x4 al = tr_rt<0>(va), ah = tr_rt<0>(va + 2048);
            const s16x4 b0l = tr_rt<0>(ka), b0h = tr_rt<0>(ka + 2048), b1l = tr_rt<0>(ka + 512), b1h = tr_rt<0>(ka + 512 + 2048);
            LDS_WAIT(); SBAR();
            const bf16x8 A = PKLH(al, ah), B0 = PKLH(b0l, b0h), B1 = PKLH(b1l, b1h);
            acc0 = MFMA32(A, B0, acc0); acc1 = MFMA32(A, B1, acc1);
        }
    float* Uo = U + ((size_t)(unit * 2 + dir) * 128 + eb * 32) * 64;
#pragma unroll
    for (int r = 0; r < 16; ++r) { const int e = crow(r, hi); Uo[e * 64 + r32] = acc0[r]; Uo[e * 64 + 32 + r32] = acc1[r]; }
    LDS_WAIT();
    __syncthreads();
}
__device__ __forceinline__ void r3_unit(int unit, const bf16_t* __restrict__ QKV, const bf16_t* __restrict__ Sst, bf16_t* __restrict__ ARr, const float* dec_f, const float* dec_b, char* lds) {
    const int tid = threadIdx.x, wid = tid >> 6, lane = tid & 63, r32 = lane & 31, hi = lane >> 5;
    const int bh = unit >> 5, c = unit & 31, b = bh >> 2, h = bh & 3;
    const long rowbase = (long)b * SEQ + c * 128;
    const float lgf = log2_sigmoid(dec_f[h]), lgb = log2_sigmoid(dec_b[h]);
#pragma unroll
    for (int i = 0; i < 4; ++i) { const int q = tid + 512 * i, key = q >> 4, cc = (q & 15) * 8;
        const bf16x8 v = *(const bf16x8*)(QKV + (rowbase + key) * NQKV + 2048 + h * 128 + cc);
        *(bf16x8*)(lds + (key >> 6) * 16384 + v_st(key & 63, cc)) = v; }
    const int rb = wid >> 1, eh = wid & 1;
    bf16x8 qf[4];
    { const bf16_t* Qp = QKV + (rowbase + 32 * rb + r32) * NQKV + 1536 + h * 64 + hi * 8;
#pragma unroll
      for (int k = 0; k < 4; ++k) qf[k] = *(const bf16x8*)(Qp + 16 * k); }
    __syncthreads();
    const int base = (int)(uintptr_t)lds + v_rd_base(lane);
    const int iq = 32 * rb + r32;
    f32x16 oa = {}, ob = {};
#pragma unroll
    for (int jb = 0; jb < 4; ++jb) {
        f32x16 s = {};
        const bf16_t* Kp = QKV + (rowbase + 32 * jb + r32) * NQKV + 1792 + h * 64 + hi * 8;
#pragma unroll
        for (int k = 0; k < 4; ++k) { const bf16x8 kf = *(const bf16x8*)(Kp + 16 * k); s = MFMA32(kf, qf[k], s); }
#pragma unroll
        for (int r = 0; r < 16; ++r) { const int j = 32 * jb + crow(r, hi); const float dl = (float)(iq - j);
            const float ex = dl >= 0.f ? dl * lgf : -dl * lgb; s[r] *= __builtin_amdgcn_exp2f(ex); }
        bf16x8 pa, pb; PK4(s, 0, pa); PK4(s, 8, pb);
        const int va = base + (jb >> 1) * 16384 + ((2 * jb) & 3) * 4096 + (2 * eh) * 512;
        const s16x4 l0 = tr_rt<0>(va), h0 = tr_rt<0>(va + 2048), l1 = tr_rt<0>(va + 4096), h1 = tr_rt<0>(va + 4096 + 2048);
        const s16x4 m0 = tr_rt<0>(va + 512), n0 = tr_rt<0>(va + 512 + 2048), m1 = tr_rt<0>(va + 512 + 4096), n1 = tr_rt<0>(va + 512 + 4096 + 2048);
        LDS_WAIT(); SBAR();
        oa = MFMA32(pa, PKLH(l0, h0), oa); oa = MFMA32(pb, PKLH(l1, h1), oa);
        ob = MFMA32(pa, PKLH(m0, n0), ob); ob = MFMA32(pb, PKLH(m1, n1), ob);
    }
    const float xf = __builtin_amdgcn_exp2f((float)(iq + 1) * lgf), xb = __builtin_amdgcn_exp2f((float)(128 - iq) * lgb);
#pragma unroll
    for (int dir = 0; dir < 2; ++dir) {
        const bf16_t* Sp = Sst + (((size_t)(bh * 32 + c) * 2 + dir) * 128 + 64 * eh + r32) * 64 + hi * 8;
#pragma unroll
        for (int k = 0; k < 4; ++k) { const bf16x8 A = scale8(qf[k], dir ? xb : xf);
            const bf16x8 B0 = *(const bf16x8*)(Sp + 16 * k), B1 = *(const bf16x8*)(Sp + 32 * 64 + 16 * k);
            oa = MFMA32(A, B0, oa); ob = MFMA32(A, B1, ob); }
    }
    float ssq[16];
#pragma unroll
    for (int r = 0; r < 16; ++r) ssq[r] = oa[r] * oa[r] + ob[r] * ob[r];
#pragma unroll
    for (int off = 1; off < 32; off <<= 1)
#pragma unroll
        for (int r = 0; r < 16; ++r) ssq[r] += __shfl_xor(ssq[r], off);
    float* part = (float*)(lds + 32768);
    if (r32 == 0) {
#pragma unroll
        for (int r = 0; r < 16; ++r) part[wid * 32 + hi * 16 + r] = ssq[r]; }
    __syncthreads();
#pragma unroll
    for (int r = 0; r < 16; ++r) { const float tot = ssq[r] + part[(wid ^ 1) * 32 + hi * 16 + r];
        const float rs = __builtin_amdgcn_rsqf(tot * (1.f / 128.f) + NORM_EPS);
        const size_t row = (size_t)(rowbase + 32 * rb + crow(r, hi));
        const bf16_t* gp = QKV + row * NQKV + 2560 + h * 128 + 64 * eh + r32;
        const float g0 = bf2f(gp[0]), g1 = bf2f(gp[32]);
        bf16_t* op = ARr + row * 512 + h * 128 + 64 * eh + r32;
        op[0] = f2bf(oa[r] * rs * g0 * __builtin_amdgcn_rcpf(1.f + __expf(-g0)));
        op[32] = f2bf(ob[r] * rs * g1 * __builtin_amdgcn_rcpf(1.f + __expf(-g1))); }
    LDS_WAIT();
    __syncthreads();
}
}

__device__ __forceinline__ int rowmap(int mode, int n, int row_off) {
    if (mode == 1) { const bool rope = (n < 1024) || (n >= 1536 && n < 2048); if (!rope) return n; const int d = n & 63; return (n & ~63) + 2 * (d & 31) + (d >> 5); }
    if (mode == 2) return 256 * (n >> 7) + (n & 127);
    if (mode == 3) return 256 * (n >> 7) + 128 + (n & 127);
    return n + row_off;
}
__device__ __forceinline__ void transpose_item(const float* __restrict__ W, int K, int N, bf16_t* __restrict__ WT, int mode, int row_off, const float* __restrict__ kscale, float* scr, int item, int lane) {
    const int nblk = N / 32, kb = item / nblk, nb = item % nblk, k0 = 64 * kb, n0 = 32 * nb;
#pragma unroll 8
    for (int i = 0; i < 32; ++i) { const int kk = 2 * i + (lane >> 5); float v = W[(size_t)(k0 + kk) * N + n0 + (lane & 31)]; if (kscale) v *= kscale[k0 + kk]; scr[kk * 33 + (lane & 31)] = v; }
    LDS_WAIT(); asm volatile("" ::: "memory");
    const int c = lane & 7;
#pragma unroll
    for (int j = 0; j < 4; ++j) { const int n = (lane >> 3) + 8 * j; const float* s = scr + (8 * c) * 33 + n;
        u32x4 o; o.x = pk2(s[0 * 33], s[1 * 33]); o.y = pk2(s[2 * 33], s[3 * 33]); o.z = pk2(s[4 * 33], s[5 * 33]); o.w = pk2(s[6 * 33], s[7 * 33]);
        *(u32x4*)(WT + (size_t)rowmap(mode, n0 + n, row_off) * K + k0 + 8 * c) = o; }
    LDS_WAIT(); asm volatile("" ::: "memory");
}

struct Args {
    const float* x; const float* g_mix; const float* w_in; const float* lq1; const float* lk1; const float* lq2; const float* lk2; const float* subg;
    const float* dec_f; const float* dec_b; const float* w_upa; const float* w_upb; const float* w_o; const float* g_ffn; const float* w_gate; const float* w_up; const float* w_down; const float* g_final;
    float* out; unsigned char* ws;
};

__global__ void __launch_bounds__(NTHREADS, 2) hybrid_fwd(Args a) {
    extern __shared__ __attribute__((aligned(16))) unsigned char lds_raw[];
    cg::grid_group grid = cg::this_grid();
    const int tid = threadIdx.x, lane = tid & 63, wave = __builtin_amdgcn_readfirstlane(tid >> 6);
    const int G = gridDim.x, bx = blockIdx.x;
    const int vcu = (G % 8 == 0) ? (bx % 8) * (G / 8) + bx / 8 : bx;
    unsigned char* ws = a.ws;
    float* rowsq1 = (float*)(ws + WS_CTL); float* rowsq2 = rowsq1 + M;
    float* cosT = (float*)(ws + WS_ROPE); float* sinT = cosT + SEQ * 32;
    bf16_t* WinT = (bf16_t*)(ws + WS_WIN); bf16_t* WupT = (bf16_t*)(ws + WS_WUP); bf16_t* WoT = (bf16_t*)(ws + WS_WO); bf16_t* WguT = (bf16_t*)(ws + WS_WGU); bf16_t* WdT = (bf16_t*)(ws + WS_WD);
    bf16_t* Sst = (bf16_t*)(ws + WS_SST);
    bf16_t* Hb = (bf16_t*)(ws + WS_H); float* Ub = (float*)(ws + WS_H); bf16_t* AR = (bf16_t*)(ws + WS_H); bf16_t* X1B = (bf16_t*)(ws + WS_H);
    bf16_t* QKV = (bf16_t*)(ws + WS_QKV); bf16_t* Mb = (bf16_t*)(ws + WS_QKV); bf16_t* HM = (bf16_t*)(ws + WS_QKV);
    bf16_t* GATES = (bf16_t*)(ws + WS_GATES);
    PG8_LAS unsigned char* lds3 = (PG8_LAS unsigned char*)lds_raw;
    char* lds = (char*)lds_raw;

    {
        float* scr = (float*)(lds + wave * 16384);
        const int gw = vcu * 8 + wave, NGW = G * 8;
        constexpr int I_IN = (DM / 64) * (NIN / 32), I_UP = (512 / 64) * (DM / 32), I_O = (DM / 64) * (DM / 32), I_G = (DM / 64) * (DFF / 32), I_D = (DFF / 64) * (DM / 32);
        constexpr int NITEMS = I_IN + 2 * I_UP + I_O + 2 * I_G + I_D;
        for (int it = gw; it < NITEMS; it += NGW) {
            int r = it;
            if (r < I_IN) { transpose_item(a.w_in, DM, NIN, WinT, 1, 0, nullptr, scr, r, lane); continue; } r -= I_IN;
            if (r < I_UP) { transpose_item(a.w_upa, 512, DM, WupT, 0, 0, nullptr, scr, r, lane); continue; } r -= I_UP;
            if (r < I_UP) { transpose_item(a.w_upb, 512, DM, WupT, 0, 1024, nullptr, scr, r, lane); continue; } r -= I_UP;
            if (r < I_O) { transpose_item(a.w_o, DM, DM, WoT, 0, 0, nullptr, scr, r, lane); continue; } r -= I_O;
            if (r < I_G) { transpose_item(a.w_gate, DM, DFF, WguT, 2, 0, a.g_ffn, scr, r, lane); continue; } r -= I_G;
            if (r < I_G) { transpose_item(a.w_up, DM, DFF, WguT, 3, 0, a.g_ffn, scr, r, lane); continue; } r -= I_G;
            transpose_item(a.w_down, DFF, DM, WdT, 0, 0, nullptr, scr, r, lane);
        }
        f32x4 gm[4];
#pragma unroll
        for (int j = 0; j < 4; ++j) gm[j] = ((const f32x4*)a.g_mix)[lane + 64 * j];
        for (int m = gw; m < M; m += NGW) {
            const f32x4* xr = (const f32x4*)(a.x + (size_t)m * DM) + lane; f32x4 v[4]; float s = 0.f;
#pragma unroll
            for (int j = 0; j < 4; ++j) { v[j] = xr[64 * j]; s += (v[j].x * v[j].x + v[j].y * v[j].y) + (v[j].z * v[j].z + v[j].w * v[j].w); }
            const float rstd = __builtin_amdgcn_rsqf(wave_sum(s) * (1.f / DM) + NORM_EPS);
            unsigned long long* o8 = (unsigned long long*)(Hb + (size_t)m * DM) + lane;
#pragma unroll
            for (int j = 0; j < 4; ++j) { const f32x4 w = v[j] * rstd * gm[j]; o8[64 * j] = (unsigned long long)pk2(w.x, w.y) | ((unsigned long long)pk2(w.z, w.w) << 32); }
        }
        for (int t = vcu * NTHREADS + tid; t < SEQ * 32; t += G * NTHREADS) {
            const int pos = t >> 5, i = t & 31;
            const float inv = (float)pow(10000.0, -(double)i / 32.0);
            const float ang = (float)pos * inv;
            const double rev = (double)ang * 0.15915494309189535; const float fr = (float)(rev - __builtin_rint(rev));
            cosT[t] = __builtin_amdgcn_cosf(fr); sinT[t] = __builtin_amdgcn_sinf(fr);
        }
    }
    grid.sync();

    {
        pg8::Gemm g{Hb, WinT, M, NIN, DM}; pg8::StaticOrder S; S.init(M, NIN, G, bx);
        EpiProj E{QKV, GATES, cosT, sinT};
#ifndef NO_EPIPROJ
        pg8::gemm_phase<EpiProj, pg8::StaticOrder, true, true>(lds3, g, S, E);
#endif
    }
    grid.sync();

#ifndef NO_R1
    for (int u = vcu; u < 512; u += G) ret::r1_unit(u, QKV, Ub, a.dec_f, a.dec_b, lds);
#endif
    grid.sync();

    for (int idx = vcu * NTHREADS + tid; idx < 16 * 2 * 8192; idx += G * NTHREADS) {
        const int el = idx & 8191, dir = (idx >> 13) & 1, bh = idx >> 14;
        const float lg = log2_sigmoid(dir ? a.dec_b[bh & 3] : a.dec_f[bh & 3]);
        const float Gc = __builtin_amdgcn_exp2f(128.f * lg);
        float S = 0.f;
#pragma unroll 8
        for (int st = 0; st < 32; ++st) { const int c = dir ? 31 - st : st; const size_t o = ((size_t)(bh * 32 + c) * 2 + dir) * 8192 + el;
            Sst[o] = f2bf(S); S = Gc * S + Ub[o]; }
    }
    grid.sync();

    {
        float la = a.lq1[lane] * a.lk1[lane], lb = a.lq2[lane] * a.lk2[lane];
        la = wave_sum(la); lb = wave_sum(lb);
        const float lam = __expf(la) - __expf(lb) + 0.2f;
#ifndef NO_ATT
        for (int u = vcu; u < 512; u += G) att::attn_unit(u >> 7, (u >> 5) & 3, u & 31, QKV, AR, a.subg, lam, lds);
#endif
#ifndef NO_R3
        for (int u = vcu; u < 512; u += G) ret::r3_unit(u, QKV, Sst, AR + (size_t)M * 512, a.dec_f, a.dec_b, lds);
#endif
    }
    grid.sync();

    {
        pg8::Gemm g{AR, WupT, 2 * M, 2048, 512}; PairOrder S; S.init(G, bx);
        EpiUp E{GATES, Mb};
#ifndef NO_EPIUP
        pg8::gemm_phase<EpiUp, PairOrder, true, true>(lds3, g, S, E);
#endif
    }
    grid.sync();

    {
        pg8::Gemm g{Mb, WoT, M, DM, DM}; pg8::StaticOrder S; S.init(M, DM, G, bx);
        EpiRes E{a.x, a.out, X1B, rowsq1};
        pg8::gemm_phase<EpiRes, pg8::StaticOrder, true, true>(lds3, g, S, E);
    }
    grid.sync();

    {
        pg8::Gemm g{X1B, WguT, M, NGU, DM}; pg8::StaticOrder S; S.init(M, NGU, G, bx);
        EpiSwiGLU E{rowsq1, HM};
#ifndef NO_EPISWIGLU
        pg8::gemm_phase<EpiSwiGLU, pg8::StaticOrder, true, true>(lds3, g, S, E);
#endif
    }
    grid.sync();

    {
        pg8::Gemm g{HM, WdT, M, DM, DFF}; pg8::StaticOrder S; S.init(M, DM, G, bx);
        EpiRes E{a.out, a.out, nullptr, rowsq2};
        pg8::gemm_phase<EpiRes, pg8::StaticOrder, true, true>(lds3, g, S, E);
    }
    grid.sync();

    {
        const int gw = vcu * 8 + wave, NGW = G * 8;
        f32x4 gf[4];
#pragma unroll
        for (int j = 0; j < 4; ++j) gf[j] = ((const f32x4*)a.g_final)[lane + 64 * j];
        for (int m = gw; m < M; m += NGW) {
            f32x4* xr = (f32x4*)(a.out + (size_t)m * DM) + lane;
            const float rstd = __builtin_amdgcn_rsqf(rowsq2[m] * (1.f / DM) + NORM_EPS);
#pragma unroll
            for (int j = 0; j < 4; ++j) xr[64 * j] = xr[64 * j] * rstd * gf[j];
        }
    }
}

extern "C" void kernel_launch(void* const* d_in, const int* in_sizes, int n_in, void* d_out, int out_size, void* d_ws, size_t ws_size, hipStream_t stream) {
    static int grid = 0;
    if (grid == 0) {
        if (n_in != 18 || in_sizes[0] != M * DM || out_size != M * DM || ws_size < WS_END) { fprintf(stderr, "kernel_launch: unexpected shapes (n_in %d, in0 %d, out %d, ws %zu)\n", n_in, n_in > 0 ? in_sizes[0] : -1, out_size, ws_size); grid = -1; return; }
        int dev = 0, cus = 0, per_cu = 0;
        if (hipGetDevice(&dev) != hipSuccess || hipDeviceGetAttribute(&cus, hipDeviceAttributeMultiprocessorCount, dev) != hipSuccess) { grid = -1; return; }
        if (hipFuncSetAttribute((const void*)hybrid_fwd, hipFuncAttributeMaxDynamicSharedMemorySize, LDS_BYTES) != hipSuccess) { fprintf(stderr, "kernel_launch: hipFuncSetAttribute failed\n"); grid = -1; return; }
        if (hipOccupancyMaxActiveBlocksPerMultiprocessor(&per_cu, (const void*)hybrid_fwd, NTHREADS, LDS_BYTES) != hipSuccess || per_cu < 1) { fprintf(stderr, "kernel_launch: occupancy query failed (%d)\n", per_cu); (void)hipGetLastError(); per_cu = 1; }
        if (per_cu > 1) per_cu = 1;
        grid = cus * per_cu;
    }
    if (grid < 0) return;
    (void)hipMemsetAsync((char*)d_ws + WS_CTL, 0, CTL_BYTES, stream);
    Args a{};
    a.x = (const float*)d_in[0]; a.g_mix = (const float*)d_in[1]; a.w_in = (const float*)d_in[2]; a.lq1 = (const float*)d_in[3]; a.lk1 = (const float*)d_in[4]; a.lq2 = (const float*)d_in[5]; a.lk2 = (const float*)d_in[6];
    a.subg = (const float*)d_in[7]; a.dec_f = (const float*)d_in[8]; a.dec_b = (const float*)d_in[9]; a.w_upa = (const float*)d_in[10]; a.w_upb = (const float*)d_in[11]; a.w_o = (const float*)d_in[12];
    a.g_ffn = (const float*)d_in[13]; a.w_gate = (const float*)d_in[14]; a.w_up = (const float*)d_in[15]; a.w_down = (const float*)d_in[16]; a.g_final = (const float*)d_in[17];
    a.out = (float*)d_out; a.ws = (unsigned char*)d_ws;
    void* args[] = {&a};
    const hipError_t e = hipLaunchCooperativeKernel((const void*)hybrid_fwd, dim3(grid), dim3(NTHREADS), args, LDS_BYTES, stream);
    if (e != hipSuccess) fprintf(stderr, "kernel_launch: cooperative launch failed: %s (grid %d)\n", hipGetErrorString(e), grid);
}
```

```cpp
#include <hip/hip_runtime.h>
#include <hip/hip_cooperative_groups.h>
#include <cstdio>
#include <cstdint>
namespace cg = cooperative_groups;
#ifndef DUP_P1
#define DUP_P1 1
#endif
#ifndef DUP_ATT
#define DUP_ATT 1
#endif
#ifndef DUP_R3
#define DUP_R3 1
#endif
#ifndef DUP_P7
#define DUP_P7 1
#endif
#ifndef DUP_R1
#define DUP_R1 1
#endif
#ifndef DUP_SYNC
#define DUP_SYNC 0
#endif
namespace pg8 {
#define PG8_LAS __attribute__((address_space(3)))
typedef unsigned short bf16_t;
typedef short bf16x8 __attribute__((ext_vector_type(8)));
typedef float f32x4 __attribute__((ext_vector_type(4)));
typedef unsigned u32x4 __attribute__((ext_vector_type(4)));
constexpr int BM = 256, BK = 64, HALF = 128, HTB = HALF * BK * 2  , STAGE_BYTES = 8 * HTB, NXCD = 8, WGM = 8;

__host__ __device__ __forceinline__ int lds_byte(int r, int c) { const int st = (r >> 4) * 2 + (c >> 5), rr = r & 15, cc = c & 31, ob = rr * 64 + cc * 2; return st * 1024 + (ob ^ (((ob >> 9) & 1) << 5)); }
__host__ __device__ __forceinline__ void stage_rc(int b, int& R, int& C) { const int st = b / 1024, sb = b % 1024, swz = sb ^ (((sb >> 9) & 1) << 5); R = (st >> 1) * 16 + swz / 64; C = (st & 1) * 32 + (swz % 64) / 2; }
__host__ __device__ __forceinline__ int perm32(int rho) { const int n = rho >> 4, i = rho & 15; return 8 * (i >> 2) + 4 * n + (i & 3); }

struct Unit { int pm, pn; };
struct Gemm { const bf16_t* A; const bf16_t* Bt; int M, N, K; };

struct StaticOrder {
    int nM, nN, nwg, G, c;
    __host__ __device__ void init(int M, int N, int G_, int c_) { nM = M / BM; nN = N / BM; nwg = nM * nN; G = G_; c = c_; }
    __host__ __device__ bool next(int i, Unit& u) const {
        const long L = (long)i * G + c; if (L >= nwg) return false;
        int wgid = (int)L; { const int q = nwg / NXCD, r = nwg % NXCD, xcd = wgid % NXCD, off = wgid / NXCD; wgid = (xcd < r ? xcd * (q + 1) : r * (q + 1) + (xcd - r) * q) + off; }
        const int nig = WGM * nN, gid = wgid / nig, fm = gid * WGM, gsz = (nM - fm) < WGM ? (nM - fm) : WGM;
        u.pm = fm + ((wgid % nig) % gsz); u.pn = (wgid % nig) / gsz; return true;
    }
    __device__ __forceinline__ void a_ready(const Unit&) const {}
    __device__ __forceinline__ void done(const Unit&) const {}
};

__device__ __forceinline__ unsigned cvt_pk_bf16(float lo, float hi) { typedef float f2_t __attribute__((ext_vector_type(2))); typedef __bf16 b2_t __attribute__((ext_vector_type(2))); f2_t v = {lo, hi}; b2_t b = __builtin_convertvector(v, b2_t); return __builtin_bit_cast(unsigned, b); }
template <class Epi, class Sched, bool ALIGN_EPI = false, bool SP2 = false>
__device__ __forceinline__ void gemm_phase(PG8_LAS unsigned char* lds, const Gemm g, const Sched& S, const Epi& E) {
    int tid_l = threadIdx.x; asm volatile("" : "+v"(tid_l));
    const int tid = tid_l, wid = __builtin_amdgcn_readfirstlane(tid >> 6), lane = tid & 63, wr = wid >> 2, wc = wid & 3, fr = lane & 15, fq = lane >> 4;
    const int K = g.K, nt = K / BK;
    unsigned voffA[2], voffB[2];
#pragma unroll
    for (int i = 0; i < 2; ++i) { int R, C; stage_rc(tid * 16 + i * 8192, R, C); const int Rb = Epi::PERM ? ((R & ~31) + perm32(R & 31)) : R;
        voffA[i] = (unsigned)(R * K + C) * 2u; voffB[i] = (unsigned)(Rb * K + C) * 2u; }
    const size_t kstep = (size_t)(BK * 2);
    const size_t hstep = (size_t)HALF * K * 2;
    const size_t tstep = 2 * hstep;
    const unsigned ldsw = (unsigned)wid * 1024u;
    const int aoff = lds_byte(wr * 64 + fr, fq * 8), boff = lds_byte(wc * 32 + fr, fq * 8);
#define PG8_SA(b, h) (((b) * 2 + (h)) * HTB)
#define PG8_SB(b, h) ((4 + (b) * 2 + (h)) * HTB)
#define PG8_STAGE(bufoff, gbase, voff) do { _Pragma("unroll") for (int _i = 0; _i < 2; ++_i) \
        __builtin_amdgcn_global_load_lds((const unsigned*)((const char*)(gbase) + (voff)[_i]), (PG8_LAS unsigned*)(lds + (bufoff) + ldsw + _i * 8192), 16, 0, 0); } while (0)
#define PG8_LDA(dst, b, h) do { _Pragma("unroll") for (int m = 0; m < 4; ++m) _Pragma("unroll") for (int k = 0; k < 2; ++k) dst[m][k] = *(const PG8_LAS bf16x8*)(lds + PG8_SA(b, h) + aoff + m * 2048 + k * 1024); } while (0)
#define PG8_LDB(dst, b, h) do { _Pragma("unroll") for (int n = 0; n < 2; ++n) _Pragma("unroll") for (int k = 0; k < 2; ++k) dst[n][k] = *(const PG8_LAS bf16x8*)(lds + PG8_SB(b, h) + boff + n * 2048 + k * 1024); } while (0)
#define PG8_MMA(ai, bj, At, Bt) do { __builtin_amdgcn_s_setprio(1); _Pragma("unroll") for (int m = 0; m < 4; ++m) _Pragma("unroll") for (int n = 0; n < 2; ++n) _Pragma("unroll") for (int k = 0; k < 2; ++k) \
        acc[ai][bj][m][n] = __builtin_amdgcn_mfma_f32_16x16x32_bf16(Bt[n][k], At[m][k], acc[ai][bj][m][n], 0, 0, 0); __builtin_amdgcn_s_setprio(0); } while (0)
#define PG8_WAIT_V(n) asm volatile("s_waitcnt vmcnt(" #n ")" ::: "memory")
#define PG8_WAIT_L(n) asm volatile("s_waitcnt lgkmcnt(" #n ")" ::: "memory")
#define PG8_BAR __builtin_amdgcn_s_barrier()
#define PG8_SCHED __builtin_amdgcn_sched_barrier(0)
    Unit cur, nxt; int ui = 0;
    if (!S.next(0, cur)) return;
    f32x4 acc[2][2][4][2];
#pragma unroll
    for (int a = 0; a < 2; ++a)
#pragma unroll
        for (int b = 0; b < 2; ++b)
#pragma unroll
            for (int m = 0; m < 4; ++m)
#pragma unroll
                for (int n = 0; n < 2; ++n) acc[a][b][m][n] = (f32x4){0.f, 0.f, 0.f, 0.f};
    bf16x8 At[4][2], B0[2][2], B1[2][2];
    const char* cA = (const char*)g.A + (size_t)cur.pm * tstep; const char* cB = (const char*)g.Bt + (size_t)cur.pn * tstep;
    S.a_ready(cur);
    if constexpr (SP2) {
        PG8_STAGE(PG8_SB(0, 0), cB, voffB); PG8_STAGE(PG8_SB(0, 1), cB + hstep, voffB); PG8_STAGE(PG8_SA(0, 0), cA, voffA); PG8_STAGE(PG8_SA(0, 1), cA + hstep, voffA);
        if (wr == 1) PG8_BAR;
        PG8_WAIT_V(2); PG8_BAR;
        PG8_STAGE(PG8_SB(1, 0), cB + kstep, voffB); PG8_STAGE(PG8_SA(1, 0), cA + kstep, voffA); PG8_STAGE(PG8_SB(1, 1), cB + hstep + kstep, voffB);
        PG8_WAIT_V(6); PG8_BAR;
    } else {
        PG8_STAGE(PG8_SB(0, 0), cB, voffB); PG8_STAGE(PG8_SA(0, 0), cA, voffA); PG8_STAGE(PG8_SB(0, 1), cB + hstep, voffB); PG8_STAGE(PG8_SA(0, 1), cA + hstep, voffA);
        if (wr == 1) PG8_BAR;
        PG8_WAIT_V(4); PG8_BAR;
        PG8_STAGE(PG8_SB(1, 0), cB + kstep, voffB); PG8_STAGE(PG8_SA(1, 0), cA + kstep, voffA); PG8_STAGE(PG8_SB(1, 1), cB + hstep + kstep, voffB);
        PG8_WAIT_V(6); PG8_BAR;
    }
    for (;;) {
        const bool has_next = S.next(ui + 1, nxt);
        const char* nA = has_next ? (const char*)g.A + (size_t)nxt.pm * tstep : cA; const char* nB = has_next ? (const char*)g.Bt + (size_t)nxt.pn * tstep : cB;
        for (int t = 0; t < nt; t += 2) {
            const bool last = (t == nt - 2);
            const char* a1 = cA + (size_t)(t + 1) * kstep;
            const char* a2 = last ? nA : cA + (size_t)(t + 2) * kstep; const char* b2 = last ? nB : cB + (size_t)(t + 2) * kstep;
            const char* a3 = a2 + kstep; const char* b3 = b2 + kstep;
            if (last && has_next) S.a_ready(nxt);
            if constexpr (SP2) {
            PG8_LDB(B0, 0, 0); PG8_LDB(B1, 0, 1); PG8_SCHED; PG8_LDA(At, 0, 0); PG8_STAGE(PG8_SA(1, 1), a1 + hstep, voffA);
            PG8_WAIT_V(8); PG8_WAIT_L(0); PG8_BAR; PG8_MMA(0, 0, At, B0); PG8_MMA(0, 1, At, B1); PG8_BAR; PG8_SCHED;
            PG8_LDA(At, 0, 1); PG8_STAGE(PG8_SB(0, 0), b2, voffB); PG8_STAGE(PG8_SB(0, 1), b2 + hstep, voffB); PG8_STAGE(PG8_SA(0, 0), a2, voffA);
            PG8_WAIT_V(8); PG8_WAIT_L(0); PG8_BAR; PG8_MMA(1, 0, At, B0); PG8_MMA(1, 1, At, B1); PG8_BAR; PG8_SCHED;
            PG8_LDB(B0, 1, 0); PG8_LDB(B1, 1, 1); PG8_SCHED; PG8_LDA(At, 1, 0); PG8_STAGE(PG8_SA(0, 1), a2 + hstep, voffA);
            PG8_WAIT_V(8); PG8_WAIT_L(0); PG8_BAR; PG8_MMA(0, 0, At, B0); PG8_MMA(0, 1, At, B1); PG8_BAR; PG8_SCHED;
            PG8_LDA(At, 1, 1); PG8_STAGE(PG8_SB(1, 0), b3, voffB); PG8_STAGE(PG8_SB(1, 1), b3 + hstep, voffB); PG8_STAGE(PG8_SA(1, 0), a3, voffA);
            PG8_WAIT_V(8); PG8_WAIT_L(0); PG8_BAR; PG8_MMA(1, 0, At, B0); PG8_MMA(1, 1, At, B1); PG8_BAR; PG8_SCHED;
            } else {
            PG8_LDB(B0, 0, 0); PG8_SCHED; PG8_LDA(At, 0, 0); PG8_STAGE(PG8_SA(1, 1), a1 + hstep, voffA);
            PG8_WAIT_L(8); PG8_BAR; PG8_WAIT_L(0); PG8_MMA(0, 0, At, B0); PG8_BAR; PG8_SCHED;
            PG8_LDB(B1, 0, 1); PG8_STAGE(PG8_SB(0, 0), b2, voffB);
            PG8_BAR; PG8_WAIT_L(0); PG8_MMA(0, 1, At, B1); PG8_BAR;
            PG8_LDA(At, 0, 1); PG8_STAGE(PG8_SA(0, 0), a2, voffA);
            PG8_BAR; PG8_WAIT_L(0); PG8_MMA(1, 0, At, B0); PG8_BAR; PG8_SCHED;
            PG8_STAGE(PG8_SB(0, 1), b2 + hstep, voffB);
            PG8_WAIT_V(6); PG8_BAR; PG8_MMA(1, 1, At, B1); PG8_BAR;
            PG8_LDB(B0, 1, 0); PG8_SCHED; PG8_LDA(At, 1, 0); PG8_STAGE(PG8_SA(0, 1), a2 + hstep, voffA);
            PG8_WAIT_L(8); PG8_BAR; PG8_WAIT_L(0); PG8_MMA(0, 0, At, B0); PG8_BAR; PG8_SCHED;
            PG8_LDB(B1, 1, 1); PG8_STAGE(PG8_SB(1, 0), b3, voffB);
            PG8_BAR; PG8_WAIT_L(0); PG8_MMA(0, 1, At, B1); PG8_BAR;
            PG8_LDA(At, 1, 1); PG8_STAGE(PG8_SA(1, 0), a3, voffA);
            PG8_BAR; PG8_WAIT_L(0); PG8_MMA(1, 0, At, B0); PG8_BAR; PG8_SCHED;
            PG8_STAGE(PG8_SB(1, 1), b3 + hstep, voffB);
            PG8_WAIT_V(6); PG8_BAR; PG8_MMA(1, 1, At, B1); PG8_BAR;
            }
        }
        if constexpr (ALIGN_EPI) { if (wr == 0) PG8_BAR; }
        if constexpr (!Epi::AFTER_DRAIN) { E(acc, cur, wr, wc, fr, fq); S.done(cur); }
        if (!has_next) break;
#pragma unroll
        for (int a = 0; a < 2; ++a)
#pragma unroll
            for (int b = 0; b < 2; ++b)
#pragma unroll
                for (int m = 0; m < 4; ++m)
#pragma unroll
                    for (int n = 0; n < 2; ++n) acc[a][b][m][n] = (f32x4){0.f, 0.f, 0.f, 0.f};
        cur = nxt; cA = nA; cB = nB; ++ui;
        if constexpr (ALIGN_EPI) { if (wr == 1) PG8_BAR; }
    }
    PG8_WAIT_V(0);
    if constexpr (!ALIGN_EPI) { if (wr == 0) PG8_BAR; }
    PG8_BAR;
    if constexpr (Epi::AFTER_DRAIN) { E.fused(acc, cur, wr, wc, fr, fq, lds, wid, lane); S.done(cur); }
#undef PG8_SA
#undef PG8_SB
#undef PG8_STAGE
#undef PG8_LDA
#undef PG8_LDB
#undef PG8_MMA
#undef PG8_WAIT_V
#undef PG8_WAIT_L
#undef PG8_BAR
#undef PG8_SCHED
}
}

constexpr int BATCH = 4, SEQ = 4096, DM = 1024, M = BATCH * SEQ;
constexpr int NQKV = 3072, NGATE = 2048, NIN = 5120, DFF = 2816, NGU = 2 * DFF;
constexpr float NORM_EPS = 1e-5f;
constexpr int NTHREADS = 512;

typedef unsigned short bf16_t;
typedef short bf16x8 __attribute__((ext_vector_type(8)));
typedef short s16x4 __attribute__((ext_vector_type(4)));
typedef float f32x4 __attribute__((ext_vector_type(4)));
typedef float f32x16 __attribute__((ext_vector_type(16)));
typedef unsigned u32x4 __attribute__((ext_vector_type(4)));
#define LAS __attribute__((address_space(3)))
#define SBAR() __builtin_amdgcn_sched_barrier(0)
#define LDS_WAIT() asm volatile("s_waitcnt lgkmcnt(0)" ::: "memory")

constexpr size_t MiB = 1u << 20;
constexpr size_t WS_CTL = 0, CTL_BYTES = 1 * MiB;
constexpr size_t WS_ROPE = 1 * MiB;
constexpr size_t WS_WIN = 2 * MiB;
constexpr size_t WS_WUP = 12 * MiB;
constexpr size_t WS_WO = 14 * MiB;
constexpr size_t WS_WGU = 16 * MiB;
constexpr size_t WS_WD = 27 * MiB;
constexpr size_t WS_SST = 33 * MiB;
constexpr size_t WS_H = 49 * MiB;
constexpr size_t WS_QKV = 81 * MiB;
constexpr size_t WS_GATES = 177 * MiB;
constexpr size_t WS_END = 241 * MiB;

constexpr int RING_BYTES = 131072, LDS_BYTES = RING_BYTES + 256;
constexpr size_t BAR_OFF = 128 * 1024;

__device__ __forceinline__ float bf2f(unsigned v) { return __uint_as_float(v << 16); }
__device__ __forceinline__ bf16_t f2bf(float f) { unsigned u = __float_as_uint(f); return (bf16_t)((u + 0x7fffu + ((u >> 16) & 1u)) >> 16); }
__device__ __forceinline__ unsigned pk2(float lo, float hi) { return pg8::cvt_pk_bf16(lo, hi); }
__device__ __forceinline__ bf16x8 scale8(bf16x8 v, float z) {
    u32x4 w = __builtin_bit_cast(u32x4, v), o;
#pragma unroll
    for (int i = 0; i < 4; ++i) { const float lo = __uint_as_float(w[i] << 16), hi = __uint_as_float(w[i] & 0xffff0000u); o[i] = pk2(lo * z, hi * z); }
    return __builtin_bit_cast(bf16x8, o);
}
__device__ __forceinline__ float wave_sum(float v) {
#pragma unroll
    for (int o = 1; o < 64; o <<= 1) v += __shfl_xor(v, o);
    return v;
}
__device__ __forceinline__ float log2_sigmoid(float x) {
    const float sp = fmaxf(-x, 0.f) + log1pf(__expf(-fabsf(x)));
    return -sp * 1.4426950408889634f;
}
__device__ __forceinline__ int crow(int r, int hi) { return (r & 3) + 8 * (r >> 2) + 4 * hi; }

using pg8::Unit;
struct EpiProj {
    static constexpr bool PERM = true, AFTER_DRAIN = false;
    bf16_t* QKV; bf16_t* GATES; const float* cosT; const float* sinT;
    __device__ __forceinline__ void operator()(const f32x4 (&acc)[2][2][4][2], const Unit& u, int wr, int wc, int fr_, int fq_) const {
        int fr = fr_, fq = fq_; asm volatile("" : "+v"(fr), "+v"(fq));
        const int pn = u.pn, row0 = u.pm * 256 + wr * 64 + fr, cl = wc * 32 + 8 * fq;
        if (pn < 12) {
            const bool rope = (pn < 4) || pn == 6 || pn == 7;
            const float rsc = (pn == 7) ? 0.125f : 1.f;
            const int i0 = (cl & 63) >> 1;
#pragma unroll
            for (int ai = 0; ai < 2; ++ai)
#pragma unroll
                for (int m = 0; m < 4; ++m) {
                    const int row = row0 + ai * 128 + m * 16;
                    f32x4 cs = {1.f, 1.f, 1.f, 1.f}, sn = {0.f, 0.f, 0.f, 0.f};
                    if (rope) { const int pos = row & (SEQ - 1); cs = *(const f32x4*)(cosT + pos * 32 + i0); sn = *(const f32x4*)(sinT + pos * 32 + i0); }
                    bf16_t* rowp = QKV + (size_t)row * NQKV + 256 * pn + cl;
#pragma unroll
                    for (int bj = 0; bj < 2; ++bj) {
                        const f32x4 v0 = acc[ai][bj][m][0], v1 = acc[ai][bj][m][1];
                        u32x4 w;
                        w.x = pk2((v0[0] * cs[0] - v0[1] * sn[0]) * rsc, (v0[1] * cs[0] + v0[0] * sn[0]) * rsc);
                        w.y = pk2((v0[2] * cs[1] - v0[3] * sn[1]) * rsc, (v0[3] * cs[1] + v0[2] * sn[1]) * rsc);
                        w.z = pk2((v1[0] * cs[2] - v1[1] * sn[2]) * rsc, (v1[1] * cs[2] + v1[0] * sn[2]) * rsc);
                        w.w = pk2((v1[2] * cs[3] - v1[3] * sn[3]) * rsc, (v1[3] * cs[3] + v1[2] * sn[3]) * rsc);
                        *(u32x4*)(rowp + bj * 128) = w;
                    }
                }
        } else {
#pragma unroll
            for (int ai = 0; ai < 2; ++ai)
#pragma unroll
                for (int m = 0; m < 4; ++m) {
                    const int row = row0 + ai * 128 + m * 16;
                    bf16_t* rowp = GATES + (size_t)row * NGATE + 256 * (pn - 12) + cl;
#pragma unroll
                    for (int bj = 0; bj < 2; ++bj) {
                        f32x4 v0 = acc[ai][bj][m][0], v1 = acc[ai][bj][m][1];
#pragma unroll
                        for (int i = 0; i < 4; ++i) { v0[i] = __builtin_amdgcn_rcpf(1.f + __expf(-v0[i])); v1[i] = __builtin_amdgcn_rcpf(1.f + __expf(-v1[i])); }
                        u32x4 w; w.x = pk2(v0[0], v0[1]); w.y = pk2(v0[2], v0[3]); w.z = pk2(v1[0], v1[1]); w.w = pk2(v1[2], v1[3]);
                        *(u32x4*)(rowp + bj * 128) = w;
                    }
                }
        }
    }
};
struct EpiUp {
    static constexpr bool PERM = true, AFTER_DRAIN = false;
    const bf16_t* GATES; bf16_t* Mb;
    __device__ __forceinline__ void operator()(const f32x4 (&acc)[2][2][4][2], const Unit& u, int wr, int wc, int fr_, int fq_) const {
        int fr = fr_, fq = fq_; asm volatile("" : "+v"(fr), "+v"(fq));
        const int which = u.pm >> 6, pm = u.pm & 63, pn = u.pn & 3;
        const int row0 = pm * 256 + wr * 64 + fr, col0 = pn * 256 + wc * 32 + 8 * fq;
#pragma unroll
        for (int ai = 0; ai < 2; ++ai)
#pragma unroll
            for (int m = 0; m < 4; ++m) {
                const int row = row0 + ai * 128 + m * 16;
#pragma unroll
                for (int bj = 0; bj < 2; ++bj) {
                    const int col = col0 + bj * 128;
                    const u32x4 g = *(const u32x4*)(GATES + (size_t)row * NGATE + which * 1024 + col);
                    const f32x4 v0 = acc[ai][bj][m][0], v1 = acc[ai][bj][m][1];
                    float o[8];
                    o[0] = v0[0] * bf2f(g.x & 0xffffu); o[1] = v0[1] * bf2f(g.x >> 16); o[2] = v0[2] * bf2f(g.y & 0xffffu); o[3] = v0[3] * bf2f(g.y >> 16);
                    o[4] = v1[0] * bf2f(g.z & 0xffffu); o[5] = v1[1] * bf2f(g.z >> 16); o[6] = v1[2] * bf2f(g.w & 0xffffu); o[7] = v1[3] * bf2f(g.w >> 16);
                    bf16_t* dst = Mb + (size_t)row * DM + col;
                    if (which) { const u32x4 p = *(const u32x4*)dst;
                        o[0] += bf2f(p.x & 0xffffu); o[1] += bf2f(p.x >> 16); o[2] += bf2f(p.y & 0xffffu); o[3] += bf2f(p.y >> 16);
                        o[4] += bf2f(p.z & 0xffffu); o[5] += bf2f(p.z >> 16); o[6] += bf2f(p.w & 0xffffu); o[7] += bf2f(p.w >> 16); }
                    u32x4 w; w.x = pk2(o[0], o[1]); w.y = pk2(o[2], o[3]); w.z = pk2(o[4], o[5]); w.w = pk2(o[6], o[7]);
                    *(u32x4*)dst = w;
                }
            }
    }
};
struct EpiRes {
    static constexpr bool PERM = true, AFTER_DRAIN = false;
    const float* xin; float* xout; bf16_t* xb; float* rowsq;
    __device__ __forceinline__ void operator()(const f32x4 (&acc)[2][2][4][2], const Unit& u, int wr, int wc, int fr_, int fq_) const {
        int fr = fr_, fq = fq_; asm volatile("" : "+v"(fr), "+v"(fq));
        const int row0 = u.pm * 256 + wr * 64 + fr, col0 = u.pn * 256 + wc * 32 + 8 * fq;
#pragma unroll
        for (int ai = 0; ai < 2; ++ai)
#pragma unroll
            for (int m = 0; m < 4; ++m) {
                const int row = row0 + ai * 128 + m * 16; float ss = 0.f;
#pragma unroll
                for (int bj = 0; bj < 2; ++bj) {
                    const size_t off = (size_t)row * DM + col0 + bj * 128;
                    const f32x4 a0 = *(const f32x4*)(xin + off), a1 = *(const f32x4*)(xin + off + 4);
                    const f32x4 v0 = acc[ai][bj][m][0] + a0, v1 = acc[ai][bj][m][1] + a1;
                    *(f32x4*)(xout + off) = v0; *(f32x4*)(xout + off + 4) = v1;
                    ss += (v0[0] * v0[0] + v0[1] * v0[1]) + (v0[2] * v0[2] + v0[3] * v0[3]) + (v1[0] * v1[0] + v1[1] * v1[1]) + (v1[2] * v1[2] + v1[3] * v1[3]);
                    if (xb) { u32x4 w; w.x = pk2(v0[0], v0[1]); w.y = pk2(v0[2], v0[3]); w.z = pk2(v1[0], v1[1]); w.w = pk2(v1[2], v1[3]); *(u32x4*)(xb + off) = w; }
                }
                ss += __shfl_xor(ss, 16); ss += __shfl_xor(ss, 32);
                if (fq == 0) atomicAdd(rowsq + row, ss);
            }
    }
};
struct EpiSwiGLU {
    static constexpr bool PERM = true, AFTER_DRAIN = false;
    const float* rowsq; bf16_t* HM;
    __device__ __forceinline__ void operator()(const f32x4 (&acc)[2][2][4][2], const Unit& u, int wr, int wc, int fr_, int fq_) const {
        int fr = fr_, fq = fq_; asm volatile("" : "+v"(fr), "+v"(fq));
        const int row0 = u.pm * 256 + wr * 64 + fr, col0 = u.pn * 128 + wc * 32 + 8 * fq;
#pragma unroll
        for (int ai = 0; ai < 2; ++ai)
#pragma unroll
            for (int m = 0; m < 4; ++m) {
                const int row = row0 + ai * 128 + m * 16;
                const float rstd = __builtin_amdgcn_rsqf(rowsq[row] * (1.f / DM) + NORM_EPS);
                const f32x4 g0 = acc[ai][0][m][0] * rstd, g1 = acc[ai][0][m][1] * rstd, u0 = acc[ai][1][m][0] * rstd, u1 = acc[ai][1][m][1] * rstd;
                float o[8];
#pragma unroll
                for (int i = 0; i < 4; ++i) { o[i] = g0[i] * __builtin_amdgcn_rcpf(1.f + __expf(-g0[i])) * u0[i]; o[4 + i] = g1[i] * __builtin_amdgcn_rcpf(1.f + __expf(-g1[i])) * u1[i]; }
                u32x4 w; w.x = pk2(o[0], o[1]); w.y = pk2(o[2], o[3]); w.z = pk2(o[4], o[5]); w.w = pk2(o[6], o[7]);
                *(u32x4*)(HM + (size_t)row * DFF + col0) = w;
            }
    }
};
struct PairOrder {
    pg8::StaticOrder base;
    __device__ void init(int G, int c) { base.init(M, DM, G, c); }
    __device__ bool next(int i, Unit& u) const { Unit t; if (!base.next(i >> 1, t)) return false; const int w = i & 1; u.pm = t.pm + 64 * w; u.pn = t.pn + 4 * w; return true; }
    __device__ __forceinline__ void a_ready(const Unit&) const {}
    __device__ __forceinline__ void done(const Unit&) const {}
};

__device__ __forceinline__ int v_st(int k, int c) { const int kk = (k & ~0xC) | ((k & 4) << 1) | ((k & 8) >> 1); return ((kk >> 3) * 4 + (c >> 5)) * 512 + ((kk & 7) * 32 + (c & 31)) * 2; }
__device__ __forceinline__ int v_rd_base(int lane) { return ((lane & 3) << 3) | (((lane >> 2) & 3) << 6) | (((lane >> 4) & 1) << 5) | (((lane >> 5) & 1) << 8); }
__host__ __device__ constexpr int v_rd_off(int d0, int ks, int half) { return d0 * 512 + ks * 4096 + half * 2048; }
template <int OFF> __device__ __forceinline__ s16x4 tr_read(int vb) { s16x4 r; asm volatile("ds_read_b64_tr_b16 %0, %1 offset:%2" : "=&v"(r) : "v"(vb), "i"(OFF) : "memory"); return r; }
#define PKLH(L, H) (bf16x8){L[0], L[1], L[2], L[3], H[0], H[1], H[2], H[3]}
#define MFMA32(a, b, c) __builtin_amdgcn_mfma_f32_32x32x16_bf16((a), (b), (c), 0, 0, 0)
#define PK4(P, BASE, OUT) do { unsigned a0_ = pk2(P[BASE + 0], P[BASE + 1]), a1_ = pk2(P[BASE + 2], P[BASE + 3]);   \
    unsigned b0_ = pk2(P[BASE + 4], P[BASE + 5]), b1_ = pk2(P[BASE + 6], P[BASE + 7]);                              \
    auto r0_ = __builtin_amdgcn_permlane32_swap(a0_, b0_, false, false); auto r1_ = __builtin_amdgcn_permlane32_swap(a1_, b1_, false, false); \
    u32x4 w_ = {r0_[0], r1_[0], r0_[1], r1_[1]}; OUT = __builtin_bit_cast(bf16x8, w_); } while (0)

namespace att {
constexpr float SCALE = 0.125f, THR = 8.f;
constexpr int SHM_V = 64 * 128 * 2, SHM_K = SHM_V, SDEPTH = 1;
#define KSWZ(row, colB) ((row) * 256 + ((colB) ^ (((row) & 7) << 4)))
__device__ __forceinline__ void partialSM(f32x16& p0, f32x16& p1, float& m_reg, float& mn, float& alpha) {
    constexpr float C = SCALE * 1.4426950408889634f;
    float pmax = p0[0];
#pragma unroll
    for (int r = 1; r < 16; ++r) pmax = fmaxf(pmax, p0[r]);
#pragma unroll
    for (int r = 0; r < 16; ++r) pmax = fmaxf(pmax, p1[r]);
    { auto rr = __builtin_amdgcn_permlane32_swap(__float_as_uint(pmax), __float_as_uint(pmax), false, false); pmax = fmaxf(__uint_as_float(rr[0]), __uint_as_float(rr[1])); }
    if (__builtin_expect(__all(pmax - m_reg <= THR / SCALE), 1)) { mn = m_reg; alpha = 1.f; }
    else { mn = fmaxf(m_reg, pmax); alpha = __builtin_amdgcn_exp2f((m_reg - mn) * C); m_reg = mn; }
    const float mnC = -mn * C;
#pragma unroll
    for (int r = 0; r < 16; ++r) p0[r] = fmaf(p0[r], C, mnC);
#pragma unroll
    for (int r = 0; r < 16; ++r) p1[r] = fmaf(p1[r], C, mnC);
#pragma unroll
    for (int r = 0; r < 16; ++r) p0[r] = __builtin_amdgcn_exp2f(p0[r]);
}
__device__ __forceinline__ void finishSM(f32x16& p0, f32x16& p1, float alpha, float& l_reg, bf16x8& pa0, bf16x8& pa1, bf16x8& pa2, bf16x8& pa3) {
#pragma unroll
    for (int r = 0; r < 16; ++r) p1[r] = __builtin_amdgcn_exp2f(p1[r]);
    float ps = 0.f;
#pragma unroll
    for (int r = 0; r < 16; ++r) ps += p0[r];
#pragma unroll
    for (int r = 0; r < 16; ++r) ps += p1[r];
    { auto rr = __builtin_amdgcn_permlane32_swap(__float_as_uint(ps), __float_as_uint(ps), false, false); ps = __uint_as_float(rr[0]) + __uint_as_float(rr[1]); }
    l_reg = l_reg * alpha + ps;
    PK4(p0, 0, pa0); PK4(p0, 8, pa1); PK4(p1, 0, pa2); PK4(p1, 8, pa3);
}
__device__ __forceinline__ void qkt(f32x16& p0, f32x16& p1, const char* Ks, const bf16x8* qr, int r32, int hi, int comp) {
    p0 = f32x16{}; p1 = f32x16{};
#pragma unroll
    for (int d0 = 0; d0 < 4; ++d0) { const int cb = (comp * 64 + d0 * 16 + hi * 8) * 2;
        const bf16x8 b0 = *(const bf16x8*)(Ks + KSWZ(r32, cb));
        const bf16x8 b1 = *(const bf16x8*)(Ks + KSWZ(32 + r32, cb));
        p0 = MFMA32(b0, qr[d0], p0); p1 = MFMA32(b1, qr[d0], p1); }
}
template <int D0> __device__ __forceinline__ void pv_one(f32x16& od, int vb, bf16x8 pa0, bf16x8 pa1, bf16x8 pa2, bf16x8 pa3) {
    const s16x4 l0 = tr_read<v_rd_off(D0, 0, 0)>(vb), h0 = tr_read<v_rd_off(D0, 0, 1)>(vb), l1 = tr_read<v_rd_off(D0, 1, 0)>(vb), h1 = tr_read<v_rd_off(D0, 1, 1)>(vb);
    const s16x4 l2 = tr_read<v_rd_off(D0, 2, 0)>(vb), h2 = tr_read<v_rd_off(D0, 2, 1)>(vb), l3 = tr_read<v_rd_off(D0, 3, 0)>(vb), h3 = tr_read<v_rd_off(D0, 3, 1)>(vb);
    LDS_WAIT(); SBAR();
    od = MFMA32(pa0, PKLH(l0, h0), od); od = MFMA32(pa1, PKLH(l1, h1), od); od = MFMA32(pa2, PKLH(l2, h2), od); od = MFMA32(pa3, PKLH(l3, h3), od);
}
__device__ __forceinline__ void pv_d0(f32x16* o, int vb, bf16x8 pa0, bf16x8 pa1, bf16x8 pa2, bf16x8 pa3) {
    pv_one<0>(o[0], vb, pa0, pa1, pa2, pa3); pv_one<1>(o[1], vb, pa0, pa1, pa2, pa3); pv_one<2>(o[2], vb, pa0, pa1, pa2, pa3); pv_one<3>(o[3], vb, pa0, pa1, pa2, pa3);
}
__device__ __forceinline__ void attn_unit(int b, int h, int qb, const bf16_t* __restrict__ QKV, bf16_t* __restrict__ AR, const float* __restrict__ subg, float lam, char* lds) {
    const int tid = threadIdx.x, wid = tid >> 6, lane = tid & 63, r32 = lane & 31, hi = lane >> 5;
    const int rb = wid >> 1, comp = wid & 1;
    char* V_lds = lds; char* K_lds = lds + 2 * SHM_V;
    float* ws = (float*)(lds + 2 * SHM_V + 2 * SHM_K) + wid * 64; float* li_l = ws; float* al_l = ws + 32;
    const long rowbase = (long)b * SEQ; const int q0 = qb * 128;
    float m_reg = -1e30f, l_reg = 0.f; f32x16 o[4] = {}; bf16x8 qr[4];
    { const bf16_t* Qw = QKV + (rowbase + q0 + rb * 32 + r32) * NQKV + h * 128 + comp * 64 + hi * 8;
#pragma unroll
      for (int d0 = 0; d0 < 4; ++d0) qr[d0] = *(const bf16x8*)(Qw + d0 * 16); }
    const bf16_t* Kh = QKV + rowbase * NQKV + 512 + h * 128; const bf16_t* Vh = QKV + rowbase * NQKV + 1024 + h * 128;
    const int sr = tid >> 4, sc = (tid & 15) * 8, vst0 = v_st(sr, sc), vst1 = v_st(32 + sr, sc);
    const int vb0 = (int)(uintptr_t)V_lds + v_rd_base(lane);
    struct { bf16x8 vs0, vs1, ks0, ks1; } sr_[SDEPTH];
#define SLOAD(i, k0) do { sr_[i].vs0 = *(const bf16x8*)(Vh + (long)((k0) + sr) * NQKV + sc); sr_[i].vs1 = *(const bf16x8*)(Vh + (long)((k0) + 32 + sr) * NQKV + sc); \
    sr_[i].ks0 = *(const bf16x8*)(Kh + (long)((k0) + sr) * NQKV + sc); sr_[i].ks1 = *(const bf16x8*)(Kh + (long)((k0) + 32 + sr) * NQKV + sc); } while (0)
#define SWRITE(bb, i) do { *(bf16x8*)(V_lds + (bb) * SHM_V + vst0) = sr_[i].vs0; *(bf16x8*)(V_lds + (bb) * SHM_V + vst1) = sr_[i].vs1; \
    *(bf16x8*)(K_lds + (bb) * SHM_K + KSWZ(sr, sc * 2)) = sr_[i].ks0; *(bf16x8*)(K_lds + (bb) * SHM_K + KSWZ(32 + sr, sc * 2)) = sr_[i].ks1; } while (0)
#define SWAIT() asm volatile("s_waitcnt vmcnt(0)" ::: "memory")
#define RESC(a) do { if (__any((a) < 1.f)) { if (hi == 0) al_l[r32] = (a); LDS_WAIT(); \
    _Pragma("unroll") for (int d = 0; d < 4; ++d) _Pragma("unroll") for (int r = 0; r < 16; ++r) o[d][r] *= al_l[crow(r, hi)]; } } while (0)
    f32x16 pA0, pA1, pB0, pB1; float mnA, mnB, alA, alB; bf16x8 pa0, pa1, pa2, pa3; constexpr int NT = SEQ / 64;
    constexpr int SE = 0, SO = SDEPTH - 1;
    SLOAD(SE, 0); asm volatile("s_waitcnt vmcnt(0)" ::: "memory"); SWRITE(0, SE); __syncthreads();
    qkt(pA0, pA1, K_lds, qr, r32, hi, comp); partialSM(pA0, pA1, m_reg, mnA, alA);
    SLOAD(SO, 64);
    SWAIT(); SWRITE(1, SO); __syncthreads();
    for (int j = 1; j + 1 < NT; j += 2) {
        SBAR(); qkt(pB0, pB1, K_lds + SHM_K, qr, r32, hi, comp);
        finishSM(pA0, pA1, alA, l_reg, pa0, pa1, pa2, pa3); SBAR();
        SLOAD(SO, (j + SDEPTH) * 64); SBAR();
        pv_d0(o, vb0, pa0, pa1, pa2, pa3); partialSM(pB0, pB1, m_reg, mnB, alB);
        __syncthreads(); SWAIT(); SWRITE(0, SE);
        RESC(alB); __syncthreads();
        SBAR(); qkt(pA0, pA1, K_lds, qr, r32, hi, comp);
        finishSM(pB0, pB1, alB, l_reg, pa0, pa1, pa2, pa3); SBAR();
        SLOAD(SE, (j + 1 + SDEPTH) * 64);
        SBAR();
        pv_d0(o, vb0 + SHM_V, pa0, pa1, pa2, pa3); partialSM(pA0, pA1, m_reg, mnA, alA);
        __syncthreads(); SWAIT(); SWRITE(1, SO);
        RESC(alA); __syncthreads();
    }
    SBAR(); qkt(pB0, pB1, K_lds + SHM_K, qr, r32, hi, comp);
    finishSM(pA0, pA1, alA, l_reg, pa0, pa1, pa2, pa3); SBAR();
    pv_d0(o, vb0, pa0, pa1, pa2, pa3); partialSM(pB0, pB1, m_reg, mnB, alB);
    __syncthreads(); RESC(alB);
    finishSM(pB0, pB1, alB, l_reg, pa0, pa1, pa2, pa3); SBAR();
    pv_d0(o, vb0 + SHM_V, pa0, pa1, pa2, pa3);
#undef SLOAD
#undef SWRITE
#undef SWAIT
#undef RESC
    if (hi == 0) li_l[r32] = (comp ? lam : 1.f) / l_reg;
    LDS_WAIT();
    float rli[16];
#pragma unroll
    for (int r = 0; r < 16; ++r) rli[r] = li_l[crow(r, hi)];
    __syncthreads();
    float* X = (float*)lds + rb * (32 * 128);
    if (comp) {
#pragma unroll
        for (int r = 0; r < 16; ++r)
#pragma unroll
            for (int d = 0; d < 4; ++d) X[crow(r, hi) * 128 + d * 32 + r32] = o[d][r] * rli[r];
    }
    __syncthreads();
    if (!comp) {
        float ssq[16];
#pragma unroll
        for (int r = 0; r < 16; ++r) { float s = 0.f;
#pragma unroll
            for (int d = 0; d < 4; ++d) { const float v = o[d][r] * rli[r] - X[crow(r, hi) * 128 + d * 32 + r32]; o[d][r] = v; s += v * v; }
            ssq[r] = s; }
#pragma unroll
        for (int off = 1; off < 32; off <<= 1)
#pragma unroll
            for (int r = 0; r < 16; ++r) ssq[r] += __shfl_xor(ssq[r], off);
        float gg[4];
#pragma unroll
        for (int d = 0; d < 4; ++d) gg[d] = subg[d * 32 + r32] * 0.8f;
#pragma unroll
        for (int r = 0; r < 16; ++r) { const float rs = __builtin_amdgcn_rsqf(ssq[r] * (1.f / 128.f) + NORM_EPS);
            bf16_t* orow = AR + (size_t)(rowbase + q0 + rb * 32 + crow(r, hi)) * 512 + h * 128 + r32;
#pragma unroll
            for (int d = 0; d < 4; ++d) orow[d * 32] = f2bf(o[d][r] * rs * gg[d]); }
    }
    LDS_WAIT();
    __syncthreads();
}
}

namespace ret {
template <int DUMMY> __device__ __forceinline__ s16x4 tr_rt(int addr) { s16x4 r; asm volatile("ds_read_b64_tr_b16 %0, %1" : "=&v"(r) : "v"(addr) : "memory"); return r; }
__device__ __forceinline__ void r1_unit(int unit, const bf16_t* __restrict__ QKV, float* __restrict__ U, const float* dec_f, const float* dec_b, char* lds) {
    const int tid = threadIdx.x, wid = tid >> 6, lane = tid & 63, r32 = lane & 31, hi = lane >> 5;
    const int bh = unit >> 5, c = unit & 31, b = bh >> 2, h = bh & 3;
    const long rowbase = (long)b * SEQ + c * 128;
    const float lgf = log2_sigmoid(dec_f[h]), lgb = log2_sigmoid(dec_b[h]);
#pragma unroll
    for (int i = 0; i < 2; ++i) { const int q = tid + 512 * i, key = q >> 3, cc = (q & 7) * 8;
        const bf16x8 v = *(const bf16x8*)(QKV + (rowbase + key) * NQKV + 1792 + h * 64 + cc);
        *(bf16x8*)(lds + (key >> 6) * 16384 + v_st(key & 63, cc)) = v; }
#pragma unroll
    for (int i = 0; i < 4; ++i) { const int q = tid + 512 * i, key = q >> 4, cc = (q & 15) * 8;
        const bf16x8 v = *(const bf16x8*)(QKV + (rowbase + key) * NQKV + 2048 + h * 128 + cc);
        const float zf = __builtin_amdgcn_exp2f((float)(127 - key) * lgf), zb = __builtin_amdgcn_exp2f((float)key * lgb);
        *(bf16x8*)(lds + 32768 + (key >> 6) * 16384 + v_st(key & 63, cc)) = scale8(v, zf);
        *(bf16x8*)(lds + 65536 + (key >> 6) * 16384 + v_st(key & 63, cc)) = scale8(v, zb); }
    __syncthreads();
    const int dir = wid >> 2, eb = wid & 3;
    const int base = (int)(uintptr_t)lds + v_rd_base(lane);
    f32x16 acc0 = {}, acc1 = {};
#pragma unroll
    for (int img = 0; img < 2; ++img)
#pragma unroll
        for (int ks = 0; ks < 4; ++ks) {
            const int va = base + 32768 + dir * 32768 + img * 16384 + eb * 512 + ks * 4096;
            const int ka = base + img * 16384 + ks * 4096;
            const s16x4 al = tr_rt<0>(va), ah = tr_rt<0>(va + 2048);
            const s16x4 b0l = tr_rt<0>(ka), b0h = tr_rt<0>(ka + 2048), b1l = tr_rt<0>(ka + 512), b1h = tr_rt<0>(ka + 512 + 2048);
            LDS_WAIT(); SBAR();
            const bf16x8 A = PKLH(al, ah), B0 = PKLH(b0l, b0h), B1 = PKLH(b1l, b1h);
            acc0 = MFMA32(A, B0, acc0); acc1 = MFMA32(A, B1, acc1);
        }
    float* Uo = U + ((size_t)(unit * 2 + dir) * 128 + eb * 32) * 64;
#pragma unroll
    for (int r = 0; r < 16; ++r) { const int e = crow(r, hi); Uo[e * 64 + r32] = acc0[r]; Uo[e * 64 + 32 + r32] = acc1[r]; }
    LDS_WAIT();
    __syncthreads();
}
__device__ __forceinline__ void r3_unit(int unit, const bf16_t* __restrict__ QKV, const bf16_t* __restrict__ Sst, bf16_t* __restrict__ ARr, const float* dec_f, const float* dec_b, char* lds) {
    const int tid = threadIdx.x, wid = tid >> 6, lane = tid & 63, r32 = lane & 31, hi = lane >> 5;
    const int bh = unit >> 5, c = unit & 31, b = bh >> 2, h = bh & 3;
    const long rowbase = (long)b * SEQ + c * 128;
    const float lgf = log2_sigmoid(dec_f[h]), lgb = log2_sigmoid(dec_b[h]);
#pragma unroll
    for (int i = 0; i < 4; ++i) { const int q = tid + 512 * i, key = q >> 4, cc = (q & 15) * 8;
        const bf16x8 v = *(const bf16x8*)(QKV + (rowbase + key) * NQKV + 2048 + h * 128 + cc);
        *(bf16x8*)(lds + (key >> 6) * 16384 + v_st(key & 63, cc)) = v; }
    const int rb = wid >> 1, eh = wid & 1;
    bf16x8 qf[4];
    { const bf16_t* Qp = QKV + (rowbase + 32 * rb + r32) * NQKV + 1536 + h * 64 + hi * 8;
#pragma unroll
      for (int k = 0; k < 4; ++k) qf[k] = *(const bf16x8*)(Qp + 16 * k); }
    __syncthreads();
    const int base = (int)(uintptr_t)lds + v_rd_base(lane);
    const int iq = 32 * rb + r32;
    f32x16 oa = {}, ob = {};
#pragma unroll
    for (int jb = 0; jb < 4; ++jb) {
        f32x16 s = {};
        const bf16_t* Kp = QKV + (rowbase + 32 * jb + r32) * NQKV + 1792 + h * 64 + hi * 8;
#pragma unroll
        for (int k = 0; k < 4; ++k) { const bf16x8 kf = *(const bf16x8*)(Kp + 16 * k); s = MFMA32(kf, qf[k], s); }
#pragma unroll
        for (int r = 0; r < 16; ++r) { const int j = 32 * jb + crow(r, hi); const float dl = (float)(iq - j);
            const float ex = dl >= 0.f ? dl * lgf : -dl * lgb; s[r] *= __builtin_amdgcn_exp2f(ex); }
        bf16x8 pa, pb; PK4(s, 0, pa); PK4(s, 8, pb);
        const int va = base + (jb >> 1) * 16384 + ((2 * jb) & 3) * 4096 + (2 * eh) * 512;
        const s16x4 l0 = tr_rt<0>(va), h0 = tr_rt<0>(va + 2048), l1 = tr_rt<0>(va + 4096), h1 = tr_rt<0>(va + 4096 + 2048);
        const s16x4 m0 = tr_rt<0>(va + 512), n0 = tr_rt<0>(va + 512 + 2048), m1 = tr_rt<0>(va + 512 + 4096), n1 = tr_rt<0>(va + 512 + 4096 + 2048);
        LDS_WAIT(); SBAR();
        oa = MFMA32(pa, PKLH(l0, h0), oa); oa = MFMA32(pb, PKLH(l1, h1), oa);
        ob = MFMA32(pa, PKLH(m0, n0), ob); ob = MFMA32(pb, PKLH(m1, n1), ob);
    }
    const float xf = __builtin_amdgcn_exp2f((float)(iq + 1) * lgf), xb = __builtin_amdgcn_exp2f((float)(128 - iq) * lgb);
#pragma unroll
    for (int dir = 0; dir < 2; ++dir) {
        const bf16_t* Sp = Sst + (((size_t)(bh * 32 + c) * 2 + dir) * 128 + 64 * eh + r32) * 64 + hi * 8;
#pragma unroll
        for (int k = 0; k < 4; ++k) { const bf16x8 A = scale8(qf[k], dir ? xb : xf);
            const bf16x8 B0 = *(const bf16x8*)(Sp + 16 * k), B1 = *(const bf16x8*)(Sp + 32 * 64 + 16 * k);
            oa = MFMA32(A, B0, oa); ob = MFMA32(A, B1, ob); }
    }
    float ssq[16];
#pragma unroll
    for (int r = 0; r < 16; ++r) ssq[r] = oa[r] * oa[r] + ob[r] * ob[r];
#pragma unroll
    for (int off = 1; off < 32; off <<= 1)
#pragma unroll
        for (int r = 0; r < 16; ++r) ssq[r] += __shfl_xor(ssq[r], off);
    float* part = (float*)(lds + 32768);
    if (r32 == 0) {
#pragma unroll
        for (int r = 0; r < 16; ++r) part[wid * 32 + hi * 16 + r] = ssq[r]; }
    __syncthreads();
#pragma unroll
    for (int r = 0; r < 16; ++r) { const float tot = ssq[r] + part[(wid ^ 1) * 32 + hi * 16 + r];
        const float rs = __builtin_amdgcn_rsqf(tot * (1.f / 128.f) + NORM_EPS);
        const size_t row = (size_t)(rowbase + 32 * rb + crow(r, hi));
        const bf16_t* gp = QKV + row * NQKV + 2560 + h * 128 + 64 * eh + r32;
        const float g0 = bf2f(gp[0]), g1 = bf2f(gp[32]);
        bf16_t* op = ARr + row * 512 + h * 128 + 64 * eh + r32;
        op[0] = f2bf(oa[r] * rs * g0 * __builtin_amdgcn_rcpf(1.f + __expf(-g0)));
        op[32] = f2bf(ob[r] * rs * g1 * __builtin_amdgcn_rcpf(1.f + __expf(-g1))); }
    LDS_WAIT();
    __syncthreads();
}
}

__device__ __forceinline__ int rowmap(int mode, int n, int row_off) {
    if (mode == 1) { const bool rope = (n < 1024) || (n >= 1536 && n < 2048); if (!rope) return n; const int d = n & 63; return (n & ~63) + 2 * (d & 31) + (d >> 5); }
    if (mode == 2) return 256 * (n >> 7) + (n & 127);
    if (mode == 3) return 256 * (n >> 7) + 128 + (n & 127);
    return n + row_off;
}
__device__ __forceinline__ void transpose_item(const float* __restrict__ W, int K, int N, bf16_t* __restrict__ WT, int mode, int row_off, const float* __restrict__ kscale, float* scr, int item, int lane) {
    const int nblk = N / 32, kb = item / nblk, nb = item % nblk, k0 = 64 * kb, n0 = 32 * nb;
#pragma unroll 8
    for (int i = 0; i < 32; ++i) { const int kk = 2 * i + (lane >> 5); float v = W[(size_t)(k0 + kk) * N + n0 + (lane & 31)]; if (kscale) v *= kscale[k0 + kk]; scr[kk * 33 + (lane & 31)] = v; }
    LDS_WAIT(); asm volatile("" ::: "memory");
    const int c = lane & 7;
#pragma unroll
    for (int j = 0; j < 4; ++j) { const int n = (lane >> 3) + 8 * j; const float* s = scr + (8 * c) * 33 + n;
        u32x4 o; o.x = pk2(s[0 * 33], s[1 * 33]); o.y = pk2(s[2 * 33], s[3 * 33]); o.z = pk2(s[4 * 33], s[5 * 33]); o.w = pk2(s[6 * 33], s[7 * 33]);
        *(u32x4*)(WT + (size_t)rowmap(mode, n0 + n, row_off) * K + k0 + 8 * c) = o; }
    LDS_WAIT(); asm volatile("" ::: "memory");
}

#define XB_TMO      128
#define XB_XCNT(j)  (256  + 64 * (j))
#define XB_XSUB(j)  (1280 + 64 * (j))
#define XB_XGEN(j)  (2304 + 64 * (j))
#define XB_TOP      3328
#define XB_TOPGEN   3392
#define XCD_BAR_WORDS 3456
#define XB_SPIN_CAP (1u << 18)

__device__ __forceinline__ unsigned xb_ld(unsigned* p)              { return __hip_atomic_load(p, __ATOMIC_RELAXED, __HIP_MEMORY_SCOPE_AGENT); }
__device__ __forceinline__ unsigned xb_add(unsigned* p, unsigned v) { return __hip_atomic_fetch_add(p, v, __ATOMIC_RELAXED, __HIP_MEMORY_SCOPE_AGENT); }
__device__ __forceinline__ unsigned xb_xcc_id() { return (unsigned)__builtin_amdgcn_s_getreg((3 << 11) | 20) & 0xFu; }
#define XB_SPIN(cond, bar) do { unsigned _sp = 0; while (cond) { __builtin_amdgcn_s_sleep(1); \
    if ((++_sp & 255u) == 0u) { if (xb_ld(&(bar)[XB_TMO])) break; if (_sp > XB_SPIN_CAP) { atomicAdd(&(bar)[XB_TMO], 1u); break; } } } } while (0)

struct XcdBarrier {
    unsigned* bar; unsigned x;
    volatile LAS unsigned* st;
};

__device__ __forceinline__ XcdBarrier xcd_barrier_post(unsigned* bar, volatile LAS unsigned* st) {
    XcdBarrier b; b.bar = bar; b.x = xb_xcc_id(); b.st = st;
    if (threadIdx.x == 0) (void)xb_add(&bar[XB_XCNT(b.x)], 1u);
    return b;
}
__device__ __forceinline__ void xcd_barrier_complete(unsigned* bar, unsigned x, unsigned& nloc, unsigned& nx) {
    const unsigned G = gridDim.x * gridDim.y * gridDim.z;
    unsigned sum, cnt, mine, sp = 0u;
    for (;;) {
        sum = 0u; cnt = 0u; mine = 0u;
#pragma unroll
        for (unsigned j = 0; j < 16; ++j) { const unsigned c = xb_ld(&bar[XB_XCNT(j)]); sum += c; cnt += (c > 0u) ? 1u : 0u; mine = (j == x) ? c : mine; }
        if (sum == G) break;
        __builtin_amdgcn_s_sleep(1);
        if ((++sp & 255u) == 0u) { if (xb_ld(&bar[XB_TMO])) break; if (sp > XB_SPIN_CAP) { atomicAdd(&bar[XB_TMO], 1u); break; } }
    }
    nloc = mine > 0u ? mine : 1u; nx = cnt > 0u ? cnt : 1u;
}

__device__ __forceinline__ void xcd_barrier(const XcdBarrier& b) {
    asm volatile("s_waitcnt vmcnt(0)" ::: "memory");
    __syncthreads();
    if (threadIdx.x == 0) {
        unsigned* bar = b.bar;
        __builtin_amdgcn_s_waitcnt(0);
        unsigned nloc = b.st[0], nx = b.st[1];
        if (nloc == 0u) { xcd_barrier_complete(bar, b.x, nloc, nx); b.st[0] = nloc; b.st[1] = nx; }
        const unsigned old = xb_add(&bar[XB_XSUB(b.x)], 1u);
        const unsigned gen = old / nloc;
        if (old + 1u == (gen + 1u) * nloc) {
            __builtin_amdgcn_fence(__ATOMIC_RELEASE, "agent");
            asm volatile("s_waitcnt vmcnt(0)" ::: "memory");
            const unsigned og = xb_add(&bar[XB_TOP], 1u);
            const unsigned tg = og / nx;
            if (og + 1u == (tg + 1u) * nx) xb_add(&bar[XB_TOPGEN], 1u);
            else XB_SPIN(xb_ld(&bar[XB_TOPGEN]) == tg, bar);
            __builtin_amdgcn_fence(__ATOMIC_ACQUIRE, "agent");
            xb_add(&bar[XB_XGEN(b.x)], 1u);
            asm volatile("s_waitcnt vmcnt(0)" ::: "memory");
        } else {
            XB_SPIN(xb_ld(&bar[XB_XGEN(b.x)]) == gen, bar);
            __builtin_amdgcn_fence(__ATOMIC_ACQUIRE, "agent");
            asm volatile("s_waitcnt vmcnt(0)" ::: "memory");
        }
    }
    __syncthreads();
}

struct Args {
    const float* x; const float* g_mix; const float* w_in; const float* lq1; const float* lk1; const float* lq2; const float* lk2; const float* subg;
    const float* dec_f; const float* dec_b; const float* w_upa; const float* w_upb; const float* w_o; const float* g_ffn; const float* w_gate; const float* w_up; const float* w_down; const float* g_final;
    float* out; unsigned char* ws;
};

__global__ void __launch_bounds__(NTHREADS, 2) hybrid_fwd(Args a) {
    extern __shared__ __attribute__((aligned(16))) unsigned char lds_raw[];
    cg::grid_group grid = cg::this_grid();
    const int tid = threadIdx.x, lane = tid & 63, wave = __builtin_amdgcn_readfirstlane(tid >> 6);
    const int G = gridDim.x, bx = blockIdx.x;
    const int vcu = (G % 8 == 0) ? (bx % 8) * (G / 8) + bx / 8 : bx;
    unsigned char* ws = a.ws;
    float* rowsq1 = (float*)(ws + WS_CTL); float* rowsq2 = rowsq1 + M;
    float* cosT = (float*)(ws + WS_ROPE); float* sinT = cosT + SEQ * 32;
    bf16_t* WinT = (bf16_t*)(ws + WS_WIN); bf16_t* WupT = (bf16_t*)(ws + WS_WUP); bf16_t* WoT = (bf16_t*)(ws + WS_WO); bf16_t* WguT = (bf16_t*)(ws + WS_WGU); bf16_t* WdT = (bf16_t*)(ws + WS_WD);
    bf16_t* Sst = (bf16_t*)(ws + WS_SST);
    bf16_t* Hb = (bf16_t*)(ws + WS_H); float* Ub = (float*)(ws + WS_H); bf16_t* AR = (bf16_t*)(ws + WS_H); bf16_t* X1B = (bf16_t*)(ws + WS_H);
    bf16_t* QKV = (bf16_t*)(ws + WS_QKV); bf16_t* Mb = (bf16_t*)(ws + WS_QKV); bf16_t* HM = (bf16_t*)(ws + WS_QKV);
    bf16_t* GATES = (bf16_t*)(ws + WS_GATES);
    PG8_LAS unsigned char* lds3 = (PG8_LAS unsigned char*)lds_raw;
    char* lds = (char*)lds_raw;
    volatile LAS unsigned* xst = (volatile LAS unsigned*)(lds3 + RING_BYTES);
    if (tid < 64) xst[tid] = 0u;
    __syncthreads();
    XcdBarrier bar = xcd_barrier_post((unsigned*)(ws + WS_CTL + BAR_OFF), xst);
    if (a.ws == nullptr) grid.sync();

    {
        float* scr = (float*)(lds + wave * 16384);
        const int gw = vcu * 8 + wave, NGW = G * 8;
        constexpr int I_IN = (DM / 64) * (NIN / 32), I_UP = (512 / 64) * (DM / 32), I_O = (DM / 64) * (DM / 32), I_G = (DM / 64) * (DFF / 32), I_D = (DFF / 64) * (DM / 32);
        constexpr int NITEMS = I_IN + 2 * I_UP + I_O + 2 * I_G + I_D;
        for (int it = gw; it < NITEMS; it += NGW) {
            int r = it;
            if (r < I_IN) { transpose_item(a.w_in, DM, NIN, WinT, 1, 0, nullptr, scr, r, lane); continue; } r -= I_IN;
            if (r < I_UP) { transpose_item(a.w_upa, 512, DM, WupT, 0, 0, nullptr, scr, r, lane); continue; } r -= I_UP;
            if (r < I_UP) { transpose_item(a.w_upb, 512, DM, WupT, 0, 1024, nullptr, scr, r, lane); continue; } r -= I_UP;
            if (r < I_O) { transpose_item(a.w_o, DM, DM, WoT, 0, 0, nullptr, scr, r, lane); continue; } r -= I_O;
            if (r < I_G) { transpose_item(a.w_gate, DM, DFF, WguT, 2, 0, a.g_ffn, scr, r, lane); continue; } r -= I_G;
            if (r < I_G) { transpose_item(a.w_up, DM, DFF, WguT, 3, 0, a.g_ffn, scr, r, lane); continue; } r -= I_G;
            transpose_item(a.w_down, DFF, DM, WdT, 0, 0, nullptr, scr, r, lane);
        }
        f32x4 gm[4];
#pragma unroll
        for (int j = 0; j < 4; ++j) gm[j] = ((const f32x4*)a.g_mix)[lane + 64 * j];
        for (int m = gw; m < M; m += NGW) {
            const f32x4* xr = (const f32x4*)(a.x + (size_t)m * DM) + lane; f32x4 v[4]; float s = 0.f;
#pragma unroll
            for (int j = 0; j < 4; ++j) { v[j] = xr[64 * j]; s += (v[j].x * v[j].x + v[j].y * v[j].y) + (v[j].z * v[j].z + v[j].w * v[j].w); }
            const float rstd = __builtin_amdgcn_rsqf(wave_sum(s) * (1.f / DM) + NORM_EPS);
            unsigned long long* o8 = (unsigned long long*)(Hb + (size_t)m * DM) + lane;
#pragma unroll
            for (int j = 0; j < 4; ++j) { const f32x4 w = v[j] * rstd * gm[j]; o8[64 * j] = (unsigned long long)pk2(w.x, w.y) | ((unsigned long long)pk2(w.z, w.w) << 32); }
        }
        for (int t = vcu * NTHREADS + tid; t < SEQ * 32; t += G * NTHREADS) {
            const int pos = t >> 5, i = t & 31;
            const float inv = (float)pow(10000.0, -(double)i / 32.0);
            const float ang = (float)pos * inv;
            const double rev = (double)ang * 0.15915494309189535; const float fr = (float)(rev - __builtin_rint(rev));
            cosT[t] = __builtin_amdgcn_cosf(fr); sinT[t] = __builtin_amdgcn_sinf(fr);
        }
    }
    xcd_barrier(bar);

    {
        pg8::Gemm g{Hb, WinT, M, NIN, DM}; pg8::StaticOrder S; S.init(M, NIN, G, bx);
        EpiProj E{QKV, GATES, cosT, sinT};
#ifndef NO_EPIPROJ
        for (int rep = 0; rep < DUP_P1; ++rep)
        pg8::gemm_phase<EpiProj, pg8::StaticOrder, true, true>(lds3, g, S, E);
#endif
    }
    xcd_barrier(bar);

    for (int rep = 0; rep < DUP_SYNC; ++rep) xcd_barrier(bar);
#ifndef NO_R1
    for (int u = vcu; u < 512 * DUP_R1; u += G) ret::r1_unit(u & 511, QKV, Ub, a.dec_f, a.dec_b, lds);
#endif
    xcd_barrier(bar);

    for (int idx = vcu * NTHREADS + tid; idx < 16 * 2 * 8192; idx += G * NTHREADS) {
        const int el = idx & 8191, dir = (idx >> 13) & 1, bh = idx >> 14;
        const float lg = log2_sigmoid(dir ? a.dec_b[bh & 3] : a.dec_f[bh & 3]);
        const float Gc = __builtin_amdgcn_exp2f(128.f * lg);
        float S = 0.f;
#pragma unroll 8
        for (int st = 0; st < 32; ++st) { const int c = dir ? 31 - st : st; const size_t o = ((size_t)(bh * 32 + c) * 2 + dir) * 8192 + el;
            Sst[o] = f2bf(S); S = Gc * S + Ub[o]; }
    }
    xcd_barrier(bar);

    {
        float la = a.lq1[lane] * a.lk1[lane], lb = a.lq2[lane] * a.lk2[lane];
        la = wave_sum(la); lb = wave_sum(lb);
        const float lam = __expf(la) - __expf(lb) + 0.2f;
#ifndef NO_ATT
        for (int u = vcu; u < 512 * DUP_ATT; u += G) att::attn_unit((u >> 7) & 3, (u >> 5) & 3, u & 31, QKV, AR, a.subg, lam, lds);
#endif
#ifndef NO_R3
        for (int u = vcu; u < 512 * DUP_R3; u += G) ret::r3_unit(u & 511, QKV, Sst, AR + (size_t)M * 512, a.dec_f, a.dec_b, lds);
#endif
    }
    xcd_barrier(bar);

    {
        pg8::Gemm g{AR, WupT, 2 * M, 2048, 512}; PairOrder S; S.init(G, bx);
        EpiUp E{GATES, Mb};
#ifndef NO_EPIUP
        pg8::gemm_phase<EpiUp, PairOrder, true, true>(lds3, g, S, E);
#endif
    }
    xcd_barrier(bar);

    {
        pg8::Gemm g{Mb, WoT, M, DM, DM}; pg8::StaticOrder S; S.init(M, DM, G, bx);
        EpiRes E{a.x, a.out, X1B, rowsq1};
        pg8::gemm_phase<EpiRes, pg8::StaticOrder, true, true>(lds3, g, S, E);
    }
    xcd_barrier(bar);

    {
        pg8::Gemm g{X1B, WguT, M, NGU, DM}; pg8::StaticOrder S; S.init(M, NGU, G, bx);
        EpiSwiGLU E{rowsq1, HM};
#ifndef NO_EPISWIGLU
        for (int rep = 0; rep < DUP_P7; ++rep)
        pg8::gemm_phase<EpiSwiGLU, pg8::StaticOrder, true, true>(lds3, g, S, E);
#endif
    }
    xcd_barrier(bar);

    {
        pg8::Gemm g{HM, WdT, M, DM, DFF}; pg8::StaticOrder S; S.init(M, DM, G, bx);
        EpiRes E{a.out, a.out, nullptr, rowsq2};
        pg8::gemm_phase<EpiRes, pg8::StaticOrder, true, true>(lds3, g, S, E);
    }
    xcd_barrier(bar);

    {
        const int gw = vcu * 8 + wave, NGW = G * 8;
        f32x4 gf[4];
#pragma unroll
        for (int j = 0; j < 4; ++j) gf[j] = ((const f32x4*)a.g_final)[lane + 64 * j];
        for (int m = gw; m < M; m += NGW) {
            f32x4* xr = (f32x4*)(a.out + (size_t)m * DM) + lane;
            const float rstd = __builtin_amdgcn_rsqf(rowsq2[m] * (1.f / DM) + NORM_EPS);
#pragma unroll
            for (int j = 0; j < 4; ++j) xr[64 * j] = xr[64 * j] * rstd * gf[j];
        }
    }
}

extern "C" void kernel_launch(void* const* d_in, const int* in_sizes, int n_in, void* d_out, int out_size, void* d_ws, size_t ws_size, hipStream_t stream) {
    static int grid = 0;
    if (grid == 0) {
        if (n_in != 18 || in_sizes[0] != M * DM || out_size != M * DM || ws_size < WS_END) { fprintf(stderr, "kernel_launch: unexpected shapes (n_in %d, in0 %d, out %d, ws %zu)\n", n_in, n_in > 0 ? in_sizes[0] : -1, out_size, ws_size); grid = -1; return; }
        int dev = 0, cus = 0, per_cu = 0;
        if (hipGetDevice(&dev) != hipSuccess || hipDeviceGetAttribute(&cus, hipDeviceAttributeMultiprocessorCount, dev) != hipSuccess) { grid = -1; return; }
        if (hipFuncSetAttribute((const void*)hybrid_fwd, hipFuncAttributeMaxDynamicSharedMemorySize, LDS_BYTES) != hipSuccess) { fprintf(stderr, "kernel_launch: hipFuncSetAttribute failed\n"); grid = -1; return; }
        if (hipOccupancyMaxActiveBlocksPerMultiprocessor(&per_cu, (const void*)hybrid_fwd, NTHREADS, LDS_BYTES) != hipSuccess || per_cu < 1) { fprintf(stderr, "kernel_launch: occupancy query failed (%d)\n", per_cu); (void)hipGetLastError(); per_cu = 1; }
        if (per_cu > 1) per_cu = 1;
        grid = cus * per_cu;
    }
    if (grid < 0) return;
    (void)hipMemsetAsync((char*)d_ws + WS_CTL, 0, CTL_BYTES, stream);
    Args a{};
    a.x = (const float*)d_in[0]; a.g_mix = (const float*)d_in[1]; a.w_in = (const float*)d_in[2]; a.lq1 = (const float*)d_in[3]; a.lk1 = (const float*)d_in[4]; a.lq2 = (const float*)d_in[5]; a.lk2 = (const float*)d_in[6];
    a.subg = (const float*)d_in[7]; a.dec_f = (const float*)d_in[8]; a.dec_b = (const float*)d_in[9]; a.w_upa = (const float*)d_in[10]; a.w_upb = (const float*)d_in[11]; a.w_o = (const float*)d_in[12];
    a.g_ffn = (const float*)d_in[13]; a.w_gate = (const float*)d_in[14]; a.w_up = (const float*)d_in[15]; a.w_down = (const float*)d_in[16]; a.g_final = (const float*)d_in[17];
    a.out = (float*)d_out; a.ws = (unsigned char*)d_ws;
    void* args[] = {&a};
    const hipError_t e = hipLaunchCooperativeKernel((const void*)hybrid_fwd, dim3(grid), dim3(NTHREADS), args, LDS_BYTES, stream);
    if (e != hipSuccess) fprintf(stderr, "kernel_launch: cooperative launch failed: %s (grid %d)\n", hipGetErrorString(e), grid);
}
```

```cpp
#include <hip/hip_runtime.h>
#include <hip/hip_cooperative_groups.h>
#include <cstdio>
#include <cstdint>
namespace cg = cooperative_groups;
#ifndef DUP_P1
#define DUP_P1 1
#endif
#ifndef DUP_ATT
#define DUP_ATT 1
#endif
#ifndef DUP_R3
#define DUP_R3 1
#endif
#ifndef DUP_P7
#define DUP_P7 1
#endif
#ifndef DUP_R1
#define DUP_R1 1
#endif
#ifndef DUP_SYNC
#define DUP_SYNC 0
#endif
#ifndef DUP_SCAN
#define DUP_SCAN 1
#endif
namespace pg8 {
#define PG8_LAS __attribute__((address_space(3)))
typedef unsigned short bf16_t;
typedef short bf16x8 __attribute__((ext_vector_type(8)));
typedef float f32x4 __attribute__((ext_vector_type(4)));
typedef unsigned u32x4 __attribute__((ext_vector_type(4)));
constexpr int BM = 256, BK = 64, HALF = 128, HTB = HALF * BK * 2  , STAGE_BYTES = 8 * HTB, NXCD = 8, WGM = 8;

__host__ __device__ __forceinline__ int lds_byte(int r, int c) { const int st = (r >> 4) * 2 + (c >> 5), rr = r & 15, cc = c & 31, ob = rr * 64 + cc * 2; return st * 1024 + (ob ^ (((ob >> 9) & 1) << 5)); }
__host__ __device__ __forceinline__ void stage_rc(int b, int& R, int& C) { const int st = b / 1024, sb = b % 1024, swz = sb ^ (((sb >> 9) & 1) << 5); R = (st >> 1) * 16 + swz / 64; C = (st & 1) * 32 + (swz % 64) / 2; }
__host__ __device__ __forceinline__ int perm32(int rho) { const int n = rho >> 4, i = rho & 15; return 8 * (i >> 2) + 4 * n + (i & 3); }

struct Unit { int pm, pn; };
struct Gemm { const bf16_t* A; const bf16_t* Bt; int M, N, K; };

struct StaticOrder {
    int nM, nN, nwg, G, c;
    __host__ __device__ void init(int M, int N, int G_, int c_) { nM = M / BM; nN = N / BM; nwg = nM * nN; G = G_; c = c_; }
    __host__ __device__ bool next(int i, Unit& u) const {
        const long L = (long)i * G + c; if (L >= nwg) return false;
        int wgid = (int)L; { const int q = nwg / NXCD, r = nwg % NXCD, xcd = wgid % NXCD, off = wgid / NXCD; wgid = (xcd < r ? xcd * (q + 1) : r * (q + 1) + (xcd - r) * q) + off; }
        const int nig = WGM * nN, gid = wgid / nig, fm = gid * WGM, gsz = (nM - fm) < WGM ? (nM - fm) : WGM;
        u.pm = fm + ((wgid % nig) % gsz); u.pn = (wgid % nig) / gsz; return true;
    }
    __device__ __forceinline__ void a_ready(const Unit&) const {}
    __device__ __forceinline__ void done(const Unit&) const {}
};

__device__ __forceinline__ unsigned cvt_pk_bf16(float lo, float hi) { typedef float f2_t __attribute__((ext_vector_type(2))); typedef __bf16 b2_t __attribute__((ext_vector_type(2))); f2_t v = {lo, hi}; b2_t b = __builtin_convertvector(v, b2_t); return __builtin_bit_cast(unsigned, b); }
template <class Epi, class Sched, bool ALIGN_EPI = false, bool SP2 = false>
__device__ __forceinline__ void gemm_phase(PG8_LAS unsigned char* lds, const Gemm g, const Sched& S, const Epi& E) {
    int tid_l = threadIdx.x; asm volatile("" : "+v"(tid_l));
    const int tid = tid_l, wid = __builtin_amdgcn_readfirstlane(tid >> 6), lane = tid & 63, wr = wid >> 2, wc = wid & 3, fr = lane & 15, fq = lane >> 4;
    const int K = g.K, nt = K / BK;
    unsigned voffA[2], voffB[2];
#pragma unroll
    for (int i = 0; i < 2; ++i) { int R, C; stage_rc(tid * 16 + i * 8192, R, C); const int Rb = Epi::PERM ? ((R & ~31) + perm32(R & 31)) : R;
        voffA[i] = (unsigned)(R * K + C) * 2u; voffB[i] = (unsigned)(Rb * K + C) * 2u; }
    const size_t kstep = (size_t)(BK * 2);
    const size_t hstep = (size_t)HALF * K * 2;
    const size_t tstep = 2 * hstep;
    const unsigned ldsw = (unsigned)wid * 1024u;
    const int aoff = lds_byte(wr * 64 + fr, fq * 8), boff = lds_byte(wc * 32 + fr, fq * 8);
#define PG8_SA(b, h) (((b) * 2 + (h)) * HTB)
#define PG8_SB(b, h) ((4 + (b) * 2 + (h)) * HTB)
#define PG8_STAGE(bufoff, gbase, voff) do { _Pragma("unroll") for (int _i = 0; _i < 2; ++_i) \
        __builtin_amdgcn_global_load_lds((const unsigned*)((const char*)(gbase) + (voff)[_i]), (PG8_LAS unsigned*)(lds + (bufoff) + ldsw + _i * 8192), 16, 0, 0); } while (0)
#define PG8_LDA(dst, b, h) do { _Pragma("unroll") for (int m = 0; m < 4; ++m) _Pragma("unroll") for (int k = 0; k < 2; ++k) dst[m][k] = *(const PG8_LAS bf16x8*)(lds + PG8_SA(b, h) + aoff + m * 2048 + k * 1024); } while (0)
#define PG8_LDB(dst, b, h) do { _Pragma("unroll") for (int n = 0; n < 2; ++n) _Pragma("unroll") for (int k = 0; k < 2; ++k) dst[n][k] = *(const PG8_LAS bf16x8*)(lds + PG8_SB(b, h) + boff + n * 2048 + k * 1024); } while (0)
#define PG8_MMA(ai, bj, At, Bt) do { __builtin_amdgcn_s_setprio(1); _Pragma("unroll") for (int m = 0; m < 4; ++m) _Pragma("unroll") for (int n = 0; n < 2; ++n) _Pragma("unroll") for (int k = 0; k < 2; ++k) \
        acc[ai][bj][m][n] = __builtin_amdgcn_mfma_f32_16x16x32_bf16(Bt[n][k], At[m][k], acc[ai][bj][m][n], 0, 0, 0); __builtin_amdgcn_s_setprio(0); } while (0)
#define PG8_WAIT_V(n) asm volatile("s_waitcnt vmcnt(" #n ")" ::: "memory")
#define PG8_WAIT_L(n) asm volatile("s_waitcnt lgkmcnt(" #n ")" ::: "memory")
#define PG8_BAR __builtin_amdgcn_s_barrier()
#define PG8_SCHED __builtin_amdgcn_sched_barrier(0)
    Unit cur, nxt; int ui = 0;
    if (!S.next(0, cur)) return;
    f32x4 acc[2][2][4][2];
#pragma unroll
    for (int a = 0; a < 2; ++a)
#pragma unroll
        for (int b = 0; b < 2; ++b)
#pragma unroll
            for (int m = 0; m < 4; ++m)
#pragma unroll
                for (int n = 0; n < 2; ++n) acc[a][b][m][n] = (f32x4){0.f, 0.f, 0.f, 0.f};
    bf16x8 At[4][2], B0[2][2], B1[2][2];
    const char* cA = (const char*)g.A + (size_t)cur.pm * tstep; const char* cB = (const char*)g.Bt + (size_t)cur.pn * tstep;
    S.a_ready(cur);
    if constexpr (SP2) {
        PG8_STAGE(PG8_SB(0, 0), cB, voffB); PG8_STAGE(PG8_SB(0, 1), cB + hstep, voffB); PG8_STAGE(PG8_SA(0, 0), cA, voffA); PG8_STAGE(PG8_SA(0, 1), cA + hstep, voffA);
        if (wr == 1) PG8_BAR;
        PG8_WAIT_V(2); PG8_BAR;
        PG8_STAGE(PG8_SB(1, 0), cB + kstep, voffB); PG8_STAGE(PG8_SA(1, 0), cA + kstep, voffA); PG8_STAGE(PG8_SB(1, 1), cB + hstep + kstep, voffB);
        PG8_WAIT_V(6); PG8_BAR;
    } else {
        PG8_STAGE(PG8_SB(0, 0), cB, voffB); PG8_STAGE(PG8_SA(0, 0), cA, voffA); PG8_STAGE(PG8_SB(0, 1), cB + hstep, voffB); PG8_STAGE(PG8_SA(0, 1), cA + hstep, voffA);
        if (wr == 1) PG8_BAR;
        PG8_WAIT_V(4); PG8_BAR;
        PG8_STAGE(PG8_SB(1, 0), cB + kstep, voffB); PG8_STAGE(PG8_SA(1, 0), cA + kstep, voffA); PG8_STAGE(PG8_SB(1, 1), cB + hstep + kstep, voffB);
        PG8_WAIT_V(6); PG8_BAR;
    }
    for (;;) {
        const bool has_next = S.next(ui + 1, nxt);
        const char* nA = has_next ? (const char*)g.A + (size_t)nxt.pm * tstep : cA; const char* nB = has_next ? (const char*)g.Bt + (size_t)nxt.pn * tstep : cB;
        for (int t = 0; t < nt; t += 2) {
            const bool last = (t == nt - 2);
            const char* a1 = cA + (size_t)(t + 1) * kstep;
            const char* a2 = last ? nA : cA + (size_t)(t + 2) * kstep; const char* b2 = last ? nB : cB + (size_t)(t + 2) * kstep;
            const char* a3 = a2 + kstep; const char* b3 = b2 + kstep;
            if (last && has_next) S.a_ready(nxt);
            if constexpr (SP2) {
            PG8_LDB(B0, 0, 0); PG8_LDB(B1, 0, 1); PG8_SCHED; PG8_LDA(At, 0, 0); PG8_STAGE(PG8_SA(1, 1), a1 + hstep, voffA);
            PG8_WAIT_V(8); PG8_WAIT_L(0); PG8_BAR; PG8_MMA(0, 0, At, B0); PG8_MMA(0, 1, At, B1); PG8_BAR; PG8_SCHED;
            PG8_LDA(At, 0, 1); PG8_STAGE(PG8_SB(0, 0), b2, voffB); PG8_STAGE(PG8_SB(0, 1), b2 + hstep, voffB); PG8_STAGE(PG8_SA(0, 0), a2, voffA);
            PG8_WAIT_V(8); PG8_WAIT_L(0); PG8_BAR; PG8_MMA(1, 0, At, B0); PG8_MMA(1, 1, At, B1); PG8_BAR; PG8_SCHED;
            PG8_LDB(B0, 1, 0); PG8_LDB(B1, 1, 1); PG8_SCHED; PG8_LDA(At, 1, 0); PG8_STAGE(PG8_SA(0, 1), a2 + hstep, voffA);
            PG8_WAIT_V(8); PG8_WAIT_L(0); PG8_BAR; PG8_MMA(0, 0, At, B0); PG8_MMA(0, 1, At, B1); PG8_BAR; PG8_SCHED;
            PG8_LDA(At, 1, 1); PG8_STAGE(PG8_SB(1, 0), b3, voffB); PG8_STAGE(PG8_SB(1, 1), b3 + hstep, voffB); PG8_STAGE(PG8_SA(1, 0), a3, voffA);
            PG8_WAIT_V(8); PG8_WAIT_L(0); PG8_BAR; PG8_MMA(1, 0, At, B0); PG8_MMA(1, 1, At, B1); PG8_BAR; PG8_SCHED;
            } else {
            PG8_LDB(B0, 0, 0); PG8_SCHED; PG8_LDA(At, 0, 0); PG8_STAGE(PG8_SA(1, 1), a1 + hstep, voffA);
            PG8_WAIT_L(8); PG8_BAR; PG8_WAIT_L(0); PG8_MMA(0, 0, At, B0); PG8_BAR; PG8_SCHED;
            PG8_LDB(B1, 0, 1); PG8_STAGE(PG8_SB(0, 0), b2, voffB);
            PG8_BAR; PG8_WAIT_L(0); PG8_MMA(0, 1, At, B1); PG8_BAR;
            PG8_LDA(At, 0, 1); PG8_STAGE(PG8_SA(0, 0), a2, voffA);
            PG8_BAR; PG8_WAIT_L(0); PG8_MMA(1, 0, At, B0); PG8_BAR; PG8_SCHED;
            PG8_STAGE(PG8_SB(0, 1), b2 + hstep, voffB);
            PG8_WAIT_V(6); PG8_BAR; PG8_MMA(1, 1, At, B1); PG8_BAR;
            PG8_LDB(B0, 1, 0); PG8_SCHED; PG8_LDA(At, 1, 0); PG8_STAGE(PG8_SA(0, 1), a2 + hstep, voffA);
            PG8_WAIT_L(8); PG8_BAR; PG8_WAIT_L(0); PG8_MMA(0, 0, At, B0); PG8_BAR; PG8_SCHED;
            PG8_LDB(B1, 1, 1); PG8_STAGE(PG8_SB(1, 0), b3, voffB);
            PG8_BAR; PG8_WAIT_L(0); PG8_MMA(0, 1, At, B1); PG8_BAR;
            PG8_LDA(At, 1, 1); PG8_STAGE(PG8_SA(1, 0), a3, voffA);
            PG8_BAR; PG8_WAIT_L(0); PG8_MMA(1, 0, At, B0); PG8_BAR; PG8_SCHED;
            PG8_STAGE(PG8_SB(1, 1), b3 + hstep, voffB);
            PG8_WAIT_V(6); PG8_BAR; PG8_MMA(1, 1, At, B1); PG8_BAR;
            }
        }
        if constexpr (ALIGN_EPI) { if (wr == 0) PG8_BAR; }
        if constexpr (!Epi::AFTER_DRAIN) { E(acc, cur, wr, wc, fr, fq); S.done(cur); }
        if (!has_next) break;
#pragma unroll
        for (int a = 0; a < 2; ++a)
#pragma unroll
            for (int b = 0; b < 2; ++b)
#pragma unroll
                for (int m = 0; m < 4; ++m)
#pragma unroll
                    for (int n = 0; n < 2; ++n) acc[a][b][m][n] = (f32x4){0.f, 0.f, 0.f, 0.f};
        cur = nxt; cA = nA; cB = nB; ++ui;
        if constexpr (ALIGN_EPI) { if (wr == 1) PG8_BAR; }
    }
    PG8_WAIT_V(0);
    if constexpr (!ALIGN_EPI) { if (wr == 0) PG8_BAR; }
    PG8_BAR;
    if constexpr (Epi::AFTER_DRAIN) { E.fused(acc, cur, wr, wc, fr, fq, lds, wid, lane); S.done(cur); }
#undef PG8_SA
#undef PG8_SB
#undef PG8_STAGE
#undef PG8_LDA
#undef PG8_LDB
#undef PG8_MMA
#undef PG8_WAIT_V
#undef PG8_WAIT_L
#undef PG8_BAR
#undef PG8_SCHED
}
}

constexpr int BATCH = 4, SEQ = 4096, DM = 1024, M = BATCH * SEQ;
constexpr int NQKV = 3072, NGATE = 2048, NIN = 5120, DFF = 2816, NGU = 2 * DFF;
constexpr float NORM_EPS = 1e-5f;
constexpr int NTHREADS = 512;

typedef unsigned short bf16_t;
typedef short bf16x8 __attribute__((ext_vector_type(8)));
typedef short s16x4 __attribute__((ext_vector_type(4)));
typedef float f32x4 __attribute__((ext_vector_type(4)));
typedef float f32x16 __attribute__((ext_vector_type(16)));
typedef unsigned u32x4 __attribute__((ext_vector_type(4)));
#define LAS __attribute__((address_space(3)))
#define SBAR() __builtin_amdgcn_sched_barrier(0)
#define LDS_WAIT() asm volatile("s_waitcnt lgkmcnt(0)" ::: "memory")

constexpr size_t MiB = 1u << 20;
constexpr size_t WS_CTL = 0, CTL_BYTES = 1 * MiB;
constexpr size_t WS_ROPE = 1 * MiB;
constexpr size_t WS_WIN = 2 * MiB;
constexpr size_t WS_WUP = 12 * MiB;
constexpr size_t WS_WO = 14 * MiB;
constexpr size_t WS_WGU = 16 * MiB;
constexpr size_t WS_WD = 27 * MiB;
constexpr size_t WS_SST = 33 * MiB;
constexpr size_t WS_H = 49 * MiB;
constexpr size_t WS_QKV = 81 * MiB;
constexpr size_t WS_GATES = 177 * MiB;
constexpr size_t WS_END = 241 * MiB;

constexpr int RING_BYTES = 131072, LDS_BYTES = RING_BYTES + 256;
constexpr size_t BAR_OFF = 128 * 1024;

__device__ __forceinline__ float bf2f(unsigned v) { return __uint_as_float(v << 16); }
__device__ __forceinline__ bf16_t f2bf(float f) { unsigned u = __float_as_uint(f); return (bf16_t)((u + 0x7fffu + ((u >> 16) & 1u)) >> 16); }
__device__ __forceinline__ unsigned pk2(float lo, float hi) { return pg8::cvt_pk_bf16(lo, hi); }
__device__ __forceinline__ bf16x8 scale8(bf16x8 v, float z) {
    u32x4 w = __builtin_bit_cast(u32x4, v), o;
#pragma unroll
    for (int i = 0; i < 4; ++i) { const float lo = __uint_as_float(w[i] << 16), hi = __uint_as_float(w[i] & 0xffff0000u); o[i] = pk2(lo * z, hi * z); }
    return __builtin_bit_cast(bf16x8, o);
}
__device__ __forceinline__ float wave_sum(float v) {
#pragma unroll
    for (int o = 1; o < 64; o <<= 1) v += __shfl_xor(v, o);
    return v;
}
__device__ __forceinline__ float log2_sigmoid(float x) {
    const float sp = fmaxf(-x, 0.f) + log1pf(__expf(-fabsf(x)));
    return -sp * 1.4426950408889634f;
}
__device__ __forceinline__ int crow(int r, int hi) { return (r & 3) + 8 * (r >> 2) + 4 * hi; }

using pg8::Unit;
struct EpiProj {
    static constexpr bool PERM = true, AFTER_DRAIN = false;
    bf16_t* QKV; bf16_t* GATES; const float* cosT; const float* sinT;
    __device__ __forceinline__ void operator()(const f32x4 (&acc)[2][2][4][2], const Unit& u, int wr, int wc, int fr_, int fq_) const {
        int fr = fr_, fq = fq_; asm volatile("" : "+v"(fr), "+v"(fq));
        const int pn = u.pn, row0 = u.pm * 256 + wr * 64 + fr, cl = wc * 32 + 8 * fq;
        if (pn < 12) {
            const bool rope = (pn < 4) || pn == 6 || pn == 7;
            const float rsc = (pn == 7) ? 0.125f : 1.f;
            const int i0 = (cl & 63) >> 1;
#pragma unroll
            for (int ai = 0; ai < 2; ++ai)
#pragma unroll
                for (int m = 0; m < 4; ++m) {
                    const int row = row0 + ai * 128 + m * 16;
                    f32x4 cs = {1.f, 1.f, 1.f, 1.f}, sn = {0.f, 0.f, 0.f, 0.f};
                    if (rope) { const int pos = row & (SEQ - 1); cs = *(const f32x4*)(cosT + pos * 32 + i0); sn = *(const f32x4*)(sinT + pos * 32 + i0); }
                    bf16_t* rowp = QKV + (size_t)row * NQKV + 256 * pn + cl;
#pragma unroll
                    for (int bj = 0; bj < 2; ++bj) {
                        const f32x4 v0 = acc[ai][bj][m][0], v1 = acc[ai][bj][m][1];
                        u32x4 w;
                        w.x = pk2((v0[0] * cs[0] - v0[1] * sn[0]) * rsc, (v0[1] * cs[0] + v0[0] * sn[0]) * rsc);
                        w.y = pk2((v0[2] * cs[1] - v0[3] * sn[1]) * rsc, (v0[3] * cs[1] + v0[2] * sn[1]) * rsc);
                        w.z = pk2((v1[0] * cs[2] - v1[1] * sn[2]) * rsc, (v1[1] * cs[2] + v1[0] * sn[2]) * rsc);
                        w.w = pk2((v1[2] * cs[3] - v1[3] * sn[3]) * rsc, (v1[3] * cs[3] + v1[2] * sn[3]) * rsc);
                        *(u32x4*)(rowp + bj * 128) = w;
                    }
                }
        } else {
#pragma unroll
            for (int ai = 0; ai < 2; ++ai)
#pragma unroll
                for (int m = 0; m < 4; ++m) {
                    const int row = row0 + ai * 128 + m * 16;
                    bf16_t* rowp = GATES + (size_t)row * NGATE + 256 * (pn - 12) + cl;
#pragma unroll
                    for (int bj = 0; bj < 2; ++bj) {
                        f32x4 v0 = acc[ai][bj][m][0], v1 = acc[ai][bj][m][1];
#pragma unroll
                        for (int i = 0; i < 4; ++i) { v0[i] = __builtin_amdgcn_rcpf(1.f + __expf(-v0[i])); v1[i] = __builtin_amdgcn_rcpf(1.f + __expf(-v1[i])); }
                        u32x4 w; w.x = pk2(v0[0], v0[1]); w.y = pk2(v0[2], v0[3]); w.z = pk2(v1[0], v1[1]); w.w = pk2(v1[2], v1[3]);
                        *(u32x4*)(rowp + bj * 128) = w;
                    }
                }
        }
    }
};
struct EpiUp {
    static constexpr bool PERM = true, AFTER_DRAIN = false;
    const bf16_t* GATES; bf16_t* Mb;
    __device__ __forceinline__ void operator()(const f32x4 (&acc)[2][2][4][2], const Unit& u, int wr, int wc, int fr_, int fq_) const {
        int fr = fr_, fq = fq_; asm volatile("" : "+v"(fr), "+v"(fq));
        const int which = u.pm >> 6, pm = u.pm & 63, pn = u.pn & 3;
        const int row0 = pm * 256 + wr * 64 + fr, col0 = pn * 256 + wc * 32 + 8 * fq;
#pragma unroll
        for (int ai = 0; ai < 2; ++ai)
#pragma unroll
            for (int m = 0; m < 4; ++m) {
                const int row = row0 + ai * 128 + m * 16;
#pragma unroll
                for (int bj = 0; bj < 2; ++bj) {
                    const int col = col0 + bj * 128;
                    const u32x4 g = *(const u32x4*)(GATES + (size_t)row * NGATE + which * 1024 + col);
                    const f32x4 v0 = acc[ai][bj][m][0], v1 = acc[ai][bj][m][1];
                    float o[8];
                    o[0] = v0[0] * bf2f(g.x & 0xffffu); o[1] = v0[1] * bf2f(g.x >> 16); o[2] = v0[2] * bf2f(g.y & 0xffffu); o[3] = v0[3] * bf2f(g.y >> 16);
                    o[4] = v1[0] * bf2f(g.z & 0xffffu); o[5] = v1[1] * bf2f(g.z >> 16); o[6] = v1[2] * bf2f(g.w & 0xffffu); o[7] = v1[3] * bf2f(g.w >> 16);
                    bf16_t* dst = Mb + (size_t)row * DM + col;
                    if (which) { const u32x4 p = *(const u32x4*)dst;
                        o[0] += bf2f(p.x & 0xffffu); o[1] += bf2f(p.x >> 16); o[2] += bf2f(p.y & 0xffffu); o[3] += bf2f(p.y >> 16);
                        o[4] += bf2f(p.z & 0xffffu); o[5] += bf2f(p.z >> 16); o[6] += bf2f(p.w & 0xffffu); o[7] += bf2f(p.w >> 16); }
                    u32x4 w; w.x = pk2(o[0], o[1]); w.y = pk2(o[2], o[3]); w.z = pk2(o[4], o[5]); w.w = pk2(o[6], o[7]);
                    *(u32x4*)dst = w;
                }
            }
    }
};
struct EpiRes {
    static constexpr bool PERM = true, AFTER_DRAIN = false;
    const float* xin; float* xout; bf16_t* xb; float* rowsq;
    __device__ __forceinline__ void operator()(const f32x4 (&acc)[2][2][4][2], const Unit& u, int wr, int wc, int fr_, int fq_) const {
        int fr = fr_, fq = fq_; asm volatile("" : "+v"(fr), "+v"(fq));
        const int row0 = u.pm * 256 + wr * 64 + fr, col0 = u.pn * 256 + wc * 32 + 8 * fq;
#pragma unroll
        for (int ai = 0; ai < 2; ++ai)
#pragma unroll
            for (int m = 0; m < 4; ++m) {
                const int row = row0 + ai * 128 + m * 16; float ss = 0.f;
#pragma unroll
                for (int bj = 0; bj < 2; ++bj) {
                    const size_t off = (size_t)row * DM + col0 + bj * 128;
                    const f32x4 a0 = *(const f32x4*)(xin + off), a1 = *(const f32x4*)(xin + off + 4);
                    const f32x4 v0 = acc[ai][bj][m][0] + a0, v1 = acc[ai][bj][m][1] + a1;
                    *(f32x4*)(xout + off) = v0; *(f32x4*)(xout + off + 4) = v1;
                    ss += (v0[0] * v0[0] + v0[1] * v0[1]) + (v0[2] * v0[2] + v0[3] * v0[3]) + (v1[0] * v1[0] + v1[1] * v1[1]) + (v1[2] * v1[2] + v1[3] * v1[3]);
                    if (xb) { u32x4 w; w.x = pk2(v0[0], v0[1]); w.y = pk2(v0[2], v0[3]); w.z = pk2(v1[0], v1[1]); w.w = pk2(v1[2], v1[3]); *(u32x4*)(xb + off) = w; }
                }
                ss += __shfl_xor(ss, 16); ss += __shfl_xor(ss, 32);
                if (fq == 0) atomicAdd(rowsq + row, ss);
            }
    }
};
struct EpiSwiGLU {
    static constexpr bool PERM = true, AFTER_DRAIN = false;
    const float* rowsq; bf16_t* HM;
    __device__ __forceinline__ void operator()(const f32x4 (&acc)[2][2][4][2], const Unit& u, int wr, int wc, int fr_, int fq_) const {
        int fr = fr_, fq = fq_; asm volatile("" : "+v"(fr), "+v"(fq));
        const int row0 = u.pm * 256 + wr * 64 + fr, col0 = u.pn * 128 + wc * 32 + 8 * fq;
#pragma unroll
        for (int ai = 0; ai < 2; ++ai)
#pragma unroll
            for (int m = 0; m < 4; ++m) {
                const int row = row0 + ai * 128 + m * 16;
                const float rstd = __builtin_amdgcn_rsqf(rowsq[row] * (1.f / DM) + NORM_EPS);
                const f32x4 g0 = acc[ai][0][m][0] * rstd, g1 = acc[ai][0][m][1] * rstd, u0 = acc[ai][1][m][0] * rstd, u1 = acc[ai][1][m][1] * rstd;
                float o[8];
#pragma unroll
                for (int i = 0; i < 4; ++i) { o[i] = g0[i] * __builtin_amdgcn_rcpf(1.f + __expf(-g0[i])) * u0[i]; o[4 + i] = g1[i] * __builtin_amdgcn_rcpf(1.f + __expf(-g1[i])) * u1[i]; }
                u32x4 w; w.x = pk2(o[0], o[1]); w.y = pk2(o[2], o[3]); w.z = pk2(o[4], o[5]); w.w = pk2(o[6], o[7]);
                *(u32x4*)(HM + (size_t)row * DFF + col0) = w;
            }
    }
};
struct PairOrder {
    pg8::StaticOrder base;
    __device__ void init(int G, int c) { base.init(M, DM, G, c); }
    __device__ bool next(int i, Unit& u) const { Unit t; if (!base.next(i >> 1, t)) return false; const int w = i & 1; u.pm = t.pm + 64 * w; u.pn = t.pn + 4 * w; return true; }
    __device__ __forceinline__ void a_ready(const Unit&) const {}
    __device__ __forceinline__ void done(const Unit&) const {}
};

__device__ __forceinline__ int v_st(int k, int c) { const int kk = (k & ~0xC) | ((k & 4) << 1) | ((k & 8) >> 1); return ((kk >> 3) * 4 + (c >> 5)) * 512 + ((kk & 7) * 32 + (c & 31)) * 2; }
__device__ __forceinline__ int v_rd_base(int lane) { return ((lane & 3) << 3) | (((lane >> 2) & 3) << 6) | (((lane >> 4) & 1) << 5) | (((lane >> 5) & 1) << 8); }
__host__ __device__ constexpr int v_rd_off(int d0, int ks, int half) { return d0 * 512 + ks * 4096 + half * 2048; }
template <int OFF> __device__ __forceinline__ s16x4 tr_read(int vb) { s16x4 r; asm volatile("ds_read_b64_tr_b16 %0, %1 offset:%2" : "=&v"(r) : "v"(vb), "i"(OFF) : "memory"); return r; }
#define PKLH(L, H) (bf16x8){L[0], L[1], L[2], L[3], H[0], H[1], H[2], H[3]}
#define MFMA32(a, b, c) __builtin_amdgcn_mfma_f32_32x32x16_bf16((a), (b), (c), 0, 0, 0)
#define PK4(P, BASE, OUT) do { unsigned a0_ = pk2(P[BASE + 0], P[BASE + 1]), a1_ = pk2(P[BASE + 2], P[BASE + 3]);   \
    unsigned b0_ = pk2(P[BASE + 4], P[BASE + 5]), b1_ = pk2(P[BASE + 6], P[BASE + 7]);                              \
    auto r0_ = __builtin_amdgcn_permlane32_swap(a0_, b0_, false, false); auto r1_ = __builtin_amdgcn_permlane32_swap(a1_, b1_, false, false); \
    u32x4 w_ = {r0_[0], r1_[0], r0_[1], r1_[1]}; OUT = __builtin_bit_cast(bf16x8, w_); } while (0)

namespace att {
constexpr float SCALE = 0.125f, THR = 8.f;
constexpr int SHM_V = 64 * 128 * 2, SHM_K = SHM_V, SDEPTH = 2;
#define KSWZ(row, colB) ((row) * 256 + ((colB) ^ (((row) & 7) << 4)))
__device__ __forceinline__ void partialSM(f32x16& p0, f32x16& p1, float& m_reg, float& mn, float& alpha) {
    constexpr float C = SCALE * 1.4426950408889634f;
    float pmax = p0[0];
#pragma unroll
    for (int r = 1; r < 16; ++r) pmax = fmaxf(pmax, p0[r]);
#pragma unroll
    for (int r = 0; r < 16; ++r) pmax = fmaxf(pmax, p1[r]);
    { auto rr = __builtin_amdgcn_permlane32_swap(__float_as_uint(pmax), __float_as_uint(pmax), false, false); pmax = fmaxf(__uint_as_float(rr[0]), __uint_as_float(rr[1])); }
    if (__builtin_expect(__all(pmax - m_reg <= THR / SCALE), 1)) { mn = m_reg; alpha = 1.f; }
    else { mn = fmaxf(m_reg, pmax); alpha = __builtin_amdgcn_exp2f((m_reg - mn) * C); m_reg = mn; }
    const float mnC = -mn * C;
#pragma unroll
    for (int r = 0; r < 16; ++r) p0[r] = fmaf(p0[r], C, mnC);
#pragma unroll
    for (int r = 0; r < 16; ++r) p1[r] = fmaf(p1[r], C, mnC);
#pragma unroll
    for (int r = 0; r < 16; ++r) p0[r] = __builtin_amdgcn_exp2f(p0[r]);
}
__device__ __forceinline__ void finishSM(f32x16& p0, f32x16& p1, float alpha, float& l_reg, bf16x8& pa0, bf16x8& pa1, bf16x8& pa2, bf16x8& pa3) {
#pragma unroll
    for (int r = 0; r < 16; ++r) p1[r] = __builtin_amdgcn_exp2f(p1[r]);
    float ps = 0.f;
#pragma unroll
    for (int r = 0; r < 16; ++r) ps += p0[r];
#pragma unroll
    for (int r = 0; r < 16; ++r) ps += p1[r];
    { auto rr = __builtin_amdgcn_permlane32_swap(__float_as_uint(ps), __float_as_uint(ps), false, false); ps = __uint_as_float(rr[0]) + __uint_as_float(rr[1]); }
    l_reg = l_reg * alpha + ps;
    PK4(p0, 0, pa0); PK4(p0, 8, pa1); PK4(p1, 0, pa2); PK4(p1, 8, pa3);
}
__device__ __forceinline__ void qkt(f32x16& p0, f32x16& p1, const char* Ks, const bf16x8* qr, int r32, int hi, int comp) {
    p0 = f32x16{}; p1 = f32x16{};
#pragma unroll
    for (int d0 = 0; d0 < 4; ++d0) { const int cb = (comp * 64 + d0 * 16 + hi * 8) * 2;
        const bf16x8 b0 = *(const bf16x8*)(Ks + KSWZ(r32, cb));
        const bf16x8 b1 = *(const bf16x8*)(Ks + KSWZ(32 + r32, cb));
        p0 = MFMA32(b0, qr[d0], p0); p1 = MFMA32(b1, qr[d0], p1); }
}
template <int D0> __device__ __forceinline__ void pv_one(f32x16& od, int vb, bf16x8 pa0, bf16x8 pa1, bf16x8 pa2, bf16x8 pa3) {
    const s16x4 l0 = tr_read<v_rd_off(D0, 0, 0)>(vb), h0 = tr_read<v_rd_off(D0, 0, 1)>(vb), l1 = tr_read<v_rd_off(D0, 1, 0)>(vb), h1 = tr_read<v_rd_off(D0, 1, 1)>(vb);
    const s16x4 l2 = tr_read<v_rd_off(D0, 2, 0)>(vb), h2 = tr_read<v_rd_off(D0, 2, 1)>(vb), l3 = tr_read<v_rd_off(D0, 3, 0)>(vb), h3 = tr_read<v_rd_off(D0, 3, 1)>(vb);
    LDS_WAIT(); SBAR();
    od = MFMA32(pa0, PKLH(l0, h0), od); od = MFMA32(pa1, PKLH(l1, h1), od); od = MFMA32(pa2, PKLH(l2, h2), od); od = MFMA32(pa3, PKLH(l3, h3), od);
}
__device__ __forceinline__ void pv_d0(f32x16* o, int vb, bf16x8 pa0, bf16x8 pa1, bf16x8 pa2, bf16x8 pa3) {
    pv_one<0>(o[0], vb, pa0, pa1, pa2, pa3); pv_one<1>(o[1], vb, pa0, pa1, pa2, pa3); pv_one<2>(o[2], vb, pa0, pa1, pa2, pa3); pv_one<3>(o[3], vb, pa0, pa1, pa2, pa3);
}
__device__ __forceinline__ void attn_unit(int b, int h, int qb, const bf16_t* __restrict__ QKV, bf16_t* __restrict__ AR, const float* __restrict__ subg, float lam, char* lds) {
    const int tid = threadIdx.x, wid = tid >> 6, lane = tid & 63, r32 = lane & 31, hi = lane >> 5;
    const int rb = wid >> 1, comp = wid & 1;
    char* V_lds = lds; char* K_lds = lds + 2 * SHM_V;
    float* ws = (float*)(lds + 2 * SHM_V + 2 * SHM_K) + wid * 64; float* li_l = ws; float* al_l = ws + 32;
    const long rowbase = (long)b * SEQ; const int q0 = qb * 128;
    float m_reg = -1e30f, l_reg = 0.f; f32x16 o[4] = {}; bf16x8 qr[4];
    { const bf16_t* Qw = QKV + (rowbase + q0 + rb * 32 + r32) * NQKV + h * 128 + comp * 64 + hi * 8;
#pragma unroll
      for (int d0 = 0; d0 < 4; ++d0) qr[d0] = *(const bf16x8*)(Qw + d0 * 16); }
    const bf16_t* Kh = QKV + rowbase * NQKV + 512 + h * 128; const bf16_t* Vh = QKV + rowbase * NQKV + 1024 + h * 128;
    const int sr = tid >> 4, sc = (tid & 15) * 8, vst0 = v_st(sr, sc), vst1 = v_st(32 + sr, sc);
    const int vb0 = (int)(uintptr_t)V_lds + v_rd_base(lane);
    struct { bf16x8 vs0, vs1, ks0, ks1; } sr_[SDEPTH];
#define SLOAD(i, k0) do { sr_[i].vs0 = *(const bf16x8*)(Vh + (long)((k0) + sr) * NQKV + sc); sr_[i].vs1 = *(const bf16x8*)(Vh + (long)((k0) + 32 + sr) * NQKV + sc); \
    sr_[i].ks0 = *(const bf16x8*)(Kh + (long)((k0) + sr) * NQKV + sc); sr_[i].ks1 = *(const bf16x8*)(Kh + (long)((k0) + 32 + sr) * NQKV + sc); } while (0)
#define SWRITE(bb, i) do { *(bf16x8*)(V_lds + (bb) * SHM_V + vst0) = sr_[i].vs0; *(bf16x8*)(V_lds + (bb) * SHM_V + vst1) = sr_[i].vs1; \
    *(bf16x8*)(K_lds + (bb) * SHM_K + KSWZ(sr, sc * 2)) = sr_[i].ks0; *(bf16x8*)(K_lds + (bb) * SHM_K + KSWZ(32 + sr, sc * 2)) = sr_[i].ks1; } while (0)
#define SWAIT() asm volatile("s_waitcnt vmcnt(4)" ::: "memory")
#define RESC(a) do { if (__any((a) < 1.f)) { if (hi == 0) al_l[r32] = (a); LDS_WAIT(); \
    _Pragma("unroll") for (int d = 0; d < 4; ++d) _Pragma("unroll") for (int r = 0; r < 16; ++r) o[d][r] *= al_l[crow(r, hi)]; } } while (0)
    f32x16 pA0, pA1, pB0, pB1; float mnA, mnB, alA, alB; bf16x8 pa0, pa1, pa2, pa3; constexpr int NT = SEQ / 64;
    constexpr int SE = 0, SO = SDEPTH - 1;
    SLOAD(SE, 0); asm volatile("s_waitcnt vmcnt(0)" ::: "memory"); SWRITE(0, SE); __syncthreads();
    qkt(pA0, pA1, K_lds, qr, r32, hi, comp); partialSM(pA0, pA1, m_reg, mnA, alA);
    SLOAD(SO, 64); SLOAD(SE, 128);
    SWAIT(); SWRITE(1, SO); __syncthreads();
    for (int j = 1; j + 1 < NT; j += 2) {
        SBAR(); qkt(pB0, pB1, K_lds + SHM_K, qr, r32, hi, comp);
        finishSM(pA0, pA1, alA, l_reg, pa0, pa1, pa2, pa3); SBAR();
        SLOAD(SO, (j + SDEPTH) * 64); SBAR();
        pv_d0(o, vb0, pa0, pa1, pa2, pa3); partialSM(pB0, pB1, m_reg, mnB, alB);
        __syncthreads(); SWAIT(); SWRITE(0, SE);
        RESC(alB); __syncthreads();
        SBAR(); qkt(pA0, pA1, K_lds, qr, r32, hi, comp);
        finishSM(pB0, pB1, alB, l_reg, pa0, pa1, pa2, pa3); SBAR();
        if (j + 3 < NT) SLOAD(SE, (j + 1 + SDEPTH) * 64);
        SBAR();
        pv_d0(o, vb0 + SHM_V, pa0, pa1, pa2, pa3); partialSM(pA0, pA1, m_reg, mnA, alA);
        __syncthreads(); SWAIT(); SWRITE(1, SO);
        RESC(alA); __syncthreads();
    }
    SBAR(); qkt(pB0, pB1, K_lds + SHM_K, qr, r32, hi, comp);
    finishSM(pA0, pA1, alA, l_reg, pa0, pa1, pa2, pa3); SBAR();
    pv_d0(o, vb0, pa0, pa1, pa2, pa3); partialSM(pB0, pB1, m_reg, mnB, alB);
    __syncthreads(); RESC(alB);
    finishSM(pB0, pB1, alB, l_reg, pa0, pa1, pa2, pa3); SBAR();
    pv_d0(o, vb0 + SHM_V, pa0, pa1, pa2, pa3);
#undef SLOAD
#undef SWRITE
#undef SWAIT
#undef RESC
    if (hi == 0) li_l[r32] = (comp ? lam : 1.f) / l_reg;
    LDS_WAIT();
    float rli[16];
#pragma unroll
    for (int r = 0; r < 16; ++r) rli[r] = li_l[crow(r, hi)];
    __syncthreads();
    float* X = (float*)lds + rb * (32 * 128);
    if (comp) {
#pragma unroll
        for (int r = 0; r < 16; ++r)
#pragma unroll
            for (int d = 0; d < 4; ++d) X[crow(r, hi) * 128 + d * 32 + r32] = o[d][r] * rli[r];
    }
    __syncthreads();
    if (!comp) {
        float ssq[16];
#pragma unroll
        for (int r = 0; r < 16; ++r) { float s = 0.f;
#pragma unroll
            for (int d = 0; d < 4; ++d) { const float v = o[d][r] * rli[r] - X[crow(r, hi) * 128 + d * 32 + r32]; o[d][r] = v; s += v * v; }
            ssq[r] = s; }
#pragma unroll
        for (int off = 1; off < 32; off <<= 1)
#pragma unroll
            for (int r = 0; r < 16; ++r) ssq[r] += __shfl_xor(ssq[r], off);
        float gg[4];
#pragma unroll
        for (int d = 0; d < 4; ++d) gg[d] = subg[d * 32 + r32] * 0.8f;
#pragma unroll
        for (int r = 0; r < 16; ++r) { const float rs = __builtin_amdgcn_rsqf(ssq[r] * (1.f / 128.f) + NORM_EPS);
            bf16_t* orow = AR + (size_t)(rowbase + q0 + rb * 32 + crow(r, hi)) * 512 + h * 128 + r32;
#pragma unroll
            for (int d = 0; d < 4; ++d) orow[d * 32] = f2bf(o[d][r] * rs * gg[d]); }
    }
    LDS_WAIT();
    __syncthreads();
}
}

namespace ret {
template <int DUMMY> __device__ __forceinline__ s16x4 tr_rt(int addr) { s16x4 r; asm volatile("ds_read_b64_tr_b16 %0, %1" : "=&v"(r) : "v"(addr) : "memory"); return r; }
__device__ __forceinline__ void r1_unit(int unit, const bf16_t* __restrict__ QKV, float* __restrict__ U, const float* dec_f, const float* dec_b, char* lds) {
    const int tid = threadIdx.x, wid = tid >> 6, lane = tid & 63, r32 = lane & 31, hi = lane >> 5;
    const int bh = unit >> 5, c = unit & 31, b = bh >> 2, h = bh & 3;
    const long rowbase = (long)b * SEQ + c * 128;
    const float lgf = log2_sigmoid(dec_f[h]), lgb = log2_sigmoid(dec_b[h]);
#pragma unroll
    for (int i = 0; i < 2; ++i) { const int q = tid + 512 * i, key = q >> 3, cc = (q & 7) * 8;
        const bf16x8 v = *(const bf16x8*)(QKV + (rowbase + key) * NQKV + 1792 + h * 64 + cc);
        *(bf16x8*)(lds + (key >> 6) * 16384 + v_st(key & 63, cc)) = v; }
#pragma unroll
    for (int i = 0; i < 4; ++i) { const int q = tid + 512 * i, key = q >> 4, cc = (q & 15) * 8;
        const bf16x8 v = *(const bf16x8*)(QKV + (rowbase + key) * NQKV + 2048 + h * 128 + cc);
        const float zf = __builtin_amdgcn_exp2f((float)(127 - key) * lgf), zb = __builtin_amdgcn_exp2f((float)key * lgb);
        *(bf16x8*)(lds + 32768 + (key >> 6) * 16384 + v_st(key & 63, cc)) = scale8(v, zf);
        *(bf16x8*)(lds + 65536 + (key >> 6) * 16384 + v_st(key & 63, cc)) = scale8(v, zb); }
    __syncthreads();
    const int dir = wid >> 2, eb = wid & 3;
    const int base = (int)(uintptr_t)lds + v_rd_base(lane);
    f32x16 acc0 = {}, acc1 = {};
#pragma unroll
    for (int img = 0; img < 2; ++img)
#pragma unroll
        for (int ks = 0; ks < 4; ++ks) {
            const int va = base + 32768 + dir * 32768 + img * 16384 + eb * 512 + ks * 4096;
            const int ka = base + img * 16384 + ks * 4096;
            const s16x4 al = tr_rt<0>(va), ah = tr_rt<0>(va + 2048);
            const s16x4 b0l = tr_rt<0>(ka), b0h = tr_rt<0>(ka + 2048), b1l = tr_rt<0>(ka + 512), b1h = tr_rt<0>(ka + 512 + 2048);
            LDS_WAIT(); SBAR();
            const bf16x8 A = PKLH(al, ah), B0 = PKLH(b0l, b0h), B1 = PKLH(b1l, b1h);
            acc0 = MFMA32(A, B0, acc0); acc1 = MFMA32(A, B1, acc1);
        }
    float* Uo = U + ((size_t)(unit * 2 + dir) * 128 + eb * 32) * 64;
#pragma unroll
    for (int r = 0; r < 16; ++r) { const int e = crow(r, hi); Uo[e * 64 + r32] = acc0[r]; Uo[e * 64 + 32 + r32] = acc1[r]; }
    LDS_WAIT();
    __syncthreads();
}
__device__ __forceinline__ void r3_unit(int unit, const bf16_t* __restrict__ QKV, const bf16_t* __restrict__ Sst, bf16_t* __restrict__ ARr, const float* dec_f, const float* dec_b, char* lds) {
    const int tid = threadIdx.x, wid = tid >> 6, lane = tid & 63, r32 = lane & 31, hi = lane >> 5;
    const int bh = unit >> 5, c = unit & 31, b = bh >> 2, h = bh & 3;
    const long rowbase = (long)b * SEQ + c * 128;
    const float lgf = log2_sigmoid(dec_f[h]), lgb = log2_sigmoid(dec_b[h]);
#pragma unroll
    for (int i = 0; i < 4; ++i) { const int q = tid + 512 * i, key = q >> 4, cc = (q & 15) * 8;
        const bf16x8 v = *(const bf16x8*)(QKV + (rowbase + key) * NQKV + 2048 + h * 128 + cc);
        *(bf16x8*)(lds + (key >> 6) * 16384 + v_st(key & 63, cc)) = v; }
    const int rb = wid >> 1, eh = wid & 1;
    bf16x8 qf[4];
    { const bf16_t* Qp = QKV + (rowbase + 32 * rb + r32) * NQKV + 1536 + h * 64 + hi * 8;
#pragma unroll
      for (int k = 0; k < 4; ++k) qf[k] = *(const bf16x8*)(Qp + 16 * k); }
    __syncthreads();
    const int base = (int)(uintptr_t)lds + v_rd_base(lane);
    const int iq = 32 * rb + r32;
    f32x16 oa = {}, ob = {};
#pragma unroll
    for (int jb = 0; jb < 4; ++jb) {
        f32x16 s = {};
        const bf16_t* Kp = QKV + (rowbase + 32 * jb + r32) * NQKV + 1792 + h * 64 + hi * 8;
#pragma unroll
        for (int k = 0; k < 4; ++k) { const bf16x8 kf = *(const bf16x8*)(Kp + 16 * k); s = MFMA32(kf, qf[k], s); }
#pragma unroll
        for (int r = 0; r < 16; ++r) { const int j = 32 * jb + crow(r, hi); const float dl = (float)(iq - j);
            const float ex = dl >= 0.f ? dl * lgf : -dl * lgb; s[r] *= __builtin_amdgcn_exp2f(ex); }
        bf16x8 pa, pb; PK4(s, 0, pa); PK4(s, 8, pb);
        const int va = base + (jb >> 1) * 16384 + ((2 * jb) & 3) * 4096 + (2 * eh) * 512;
        const s16x4 l0 = tr_rt<0>(va), h0 = tr_rt<0>(va + 2048), l1 = tr_rt<0>(va + 4096), h1 = tr_rt<0>(va + 4096 + 2048);
        const s16x4 m0 = tr_rt<0>(va + 512), n0 = tr_rt<0>(va + 512 + 2048), m1 = tr_rt<0>(va + 512 + 4096), n1 = tr_rt<0>(va + 512 + 4096 + 2048);
        LDS_WAIT(); SBAR();
        oa = MFMA32(pa, PKLH(l0, h0), oa); oa = MFMA32(pb, PKLH(l1, h1), oa);
        ob = MFMA32(pa, PKLH(m0, n0), ob); ob = MFMA32(pb, PKLH(m1, n1), ob);
    }
    const float xf = __builtin_amdgcn_exp2f((float)(iq + 1) * lgf), xb = __builtin_amdgcn_exp2f((float)(128 - iq) * lgb);
#pragma unroll
    for (int dir = 0; dir < 2; ++dir) {
        const bf16_t* Sp = Sst + (((size_t)(bh * 32 + c) * 2 + dir) * 128 + 64 * eh + r32) * 64 + hi * 8;
#pragma unroll
        for (int k = 0; k < 4; ++k) { const bf16x8 A = scale8(qf[k], dir ? xb : xf);
            const bf16x8 B0 = *(const bf16x8*)(Sp + 16 * k), B1 = *(const bf16x8*)(Sp + 32 * 64 + 16 * k);
            oa = MFMA32(A, B0, oa); ob = MFMA32(A, B1, ob); }
    }
    float ssq[16];
#pragma unroll
    for (int r = 0; r < 16; ++r) ssq[r] = oa[r] * oa[r] + ob[r] * ob[r];
#pragma unroll
    for (int off = 1; off < 32; off <<= 1)
#pragma unroll
        for (int r = 0; r < 16; ++r) ssq[r] += __shfl_xor(ssq[r], off);
    float* part = (float*)(lds + 32768);
    if (r32 == 0) {
#pragma unroll
        for (int r = 0; r < 16; ++r) part[wid * 32 + hi * 16 + r] = ssq[r]; }
    __syncthreads();
#pragma unroll
    for (int r = 0; r < 16; ++r) { const float tot = ssq[r] + part[(wid ^ 1) * 32 + hi * 16 + r];
        const float rs = __builtin_amdgcn_rsqf(tot * (1.f / 128.f) + NORM_EPS);
        const size_t row = (size_t)(rowbase + 32 * rb + crow(r, hi));
        const bf16_t* gp = QKV + row * NQKV + 2560 + h * 128 + 64 * eh + r32;
        const float g0 = bf2f(gp[0]), g1 = bf2f(gp[32]);
        bf16_t* op = ARr + row * 512 + h * 128 + 64 * eh + r32;
        op[0] = f2bf(oa[r] * rs * g0 * __builtin_amdgcn_rcpf(1.f + __expf(-g0)));
        op[32] = f2bf(ob[r] * rs * g1 * __builtin_amdgcn_rcpf(1.f + __expf(-g1))); }
    LDS_WAIT();
    __syncthreads();
}
}

__device__ __forceinline__ int rowmap(int mode, int n, int row_off) {
    if (mode == 1) { const bool rope = (n < 1024) || (n >= 1536 && n < 2048); if (!rope) return n; const int d = n & 63; return (n & ~63) + 2 * (d & 31) + (d >> 5); }
    if (mode == 2) return 256 * (n >> 7) + (n & 127);
    if (mode == 3) return 256 * (n >> 7) + 128 + (n & 127);
    return n + row_off;
}
__device__ __forceinline__ void transpose_item(const float* __restrict__ W, int K, int N, bf16_t* __restrict__ WT, int mode, int row_off, const float* __restrict__ kscale, float* scr, int item, int lane) {
    const int nblk = N / 32, kb = item / nblk, nb = item % nblk, k0 = 64 * kb, n0 = 32 * nb;
#pragma unroll 8
    for (int i = 0; i < 32; ++i) { const int kk = 2 * i + (lane >> 5); float v = W[(size_t)(k0 + kk) * N + n0 + (lane & 31)]; if (kscale) v *= kscale[k0 + kk]; scr[kk * 33 + (lane & 31)] = v; }
    LDS_WAIT(); asm volatile("" ::: "memory");
    const int c = lane & 7;
#pragma unroll
    for (int j = 0; j < 4; ++j) { const int n = (lane >> 3) + 8 * j; const float* s = scr + (8 * c) * 33 + n;
        u32x4 o; o.x = pk2(s[0 * 33], s[1 * 33]); o.y = pk2(s[2 * 33], s[3 * 33]); o.z = pk2(s[4 * 33], s[5 * 33]); o.w = pk2(s[6 * 33], s[7 * 33]);
        *(u32x4*)(WT + (size_t)rowmap(mode, n0 + n, row_off) * K + k0 + 8 * c) = o; }
    LDS_WAIT(); asm volatile("" ::: "memory");
}

#define XB_TMO      128
#define XB_XCNT(j)  (256  + 64 * (j))
#define XB_XSUB(j)  (1280 + 64 * (j))
#define XB_XGEN(j)  (2304 + 64 * (j))
#define XB_TOP      3328
#define XB_TOPGEN   3392
#define XCD_BAR_WORDS 3456
#define XB_SPIN_CAP (1u << 18)

__device__ __forceinline__ unsigned xb_ld(unsigned* p)              { return __hip_atomic_load(p, __ATOMIC_RELAXED, __HIP_MEMORY_SCOPE_AGENT); }
__device__ __forceinline__ unsigned xb_add(unsigned* p, unsigned v) { return __hip_atomic_fetch_add(p, v, __ATOMIC_RELAXED, __HIP_MEMORY_SCOPE_AGENT); }
__device__ __forceinline__ unsigned xb_xcc_id() { return (unsigned)__builtin_amdgcn_s_getreg((3 << 11) | 20) & 0xFu; }
#define XB_SPIN(cond, bar) do { unsigned _sp = 0; while (cond) { __builtin_amdgcn_s_sleep(1); \
    if ((++_sp & 255u) == 0u) { if (xb_ld(&(bar)[XB_TMO])) break; if (_sp > XB_SPIN_CAP) { atomicAdd(&(bar)[XB_TMO], 1u); break; } } } } while (0)

struct XcdBarrier {
    unsigned* bar; unsigned x;
    volatile LAS unsigned* st;
};

__device__ __forceinline__ XcdBarrier xcd_barrier_post(unsigned* bar, volatile LAS unsigned* st) {
    XcdBarrier b; b.bar = bar; b.x = xb_xcc_id(); b.st = st;
    if (threadIdx.x == 0) (void)xb_add(&bar[XB_XCNT(b.x)], 1u);
    return b;
}
__device__ __forceinline__ void xcd_barrier_complete(unsigned* bar, unsigned x, unsigned& nloc, unsigned& nx) {
    const unsigned G = gridDim.x * gridDim.y * gridDim.z;
    unsigned sum, cnt, mine, sp = 0u;
    for (;;) {
        sum = 0u; cnt = 0u; mine = 0u;
#pragma unroll
        for (unsigned j = 0; j < 16; ++j) { const unsigned c = xb_ld(&bar[XB_XCNT(j)]); sum += c; cnt += (c > 0u) ? 1u : 0u; mine = (j == x) ? c : mine; }
        if (sum == G) break;
        __builtin_amdgcn_s_sleep(1);
        if ((++sp & 255u) == 0u) { if (xb_ld(&bar[XB_TMO])) break; if (sp > XB_SPIN_CAP) { atomicAdd(&bar[XB_TMO], 1u); break; } }
    }
    nloc = mine > 0u ? mine : 1u; nx = cnt > 0u ? cnt : 1u;
}

__device__ __forceinline__ void xcd_barrier(const XcdBarrier& b) {
    asm volatile("s_waitcnt vmcnt(0)" ::: "memory");
    __syncthreads();
    if (threadIdx.x == 0) {
        unsigned* bar = b.bar;
        __builtin_amdgcn_s_waitcnt(0);
        unsigned nloc = b.st[0], nx = b.st[1];
        if (nloc == 0u) { xcd_barrier_complete(bar, b.x, nloc, nx); b.st[0] = nloc; b.st[1] = nx; }
        const unsigned old = xb_add(&bar[XB_XSUB(b.x)], 1u);
        const unsigned gen = old / nloc;
        if (old + 1u == (gen + 1u) * nloc) {
            __builtin_amdgcn_fence(__ATOMIC_RELEASE, "agent");
            asm volatile("s_waitcnt vmcnt(0)" ::: "memory");
            const unsigned og = xb_add(&bar[XB_TOP], 1u);
            const unsigned tg = og / nx;
            if (og + 1u == (tg + 1u) * nx) xb_add(&bar[XB_TOPGEN], 1u);
            else XB_SPIN(xb_ld(&bar[XB_TOPGEN]) == tg, bar);
            __builtin_amdgcn_fence(__ATOMIC_ACQUIRE, "agent");
            xb_add(&bar[XB_XGEN(b.x)], 1u);
            asm volatile("s_waitcnt vmcnt(0)" ::: "memory");
        } else {
            XB_SPIN(xb_ld(&bar[XB_XGEN(b.x)]) == gen, bar);
            __builtin_amdgcn_fence(__ATOMIC_ACQUIRE, "agent");
            asm volatile("s_waitcnt vmcnt(0)" ::: "memory");
        }
    }
    __syncthreads();
}

struct Args {
    const float* x; const float* g_mix; const float* w_in; const float* lq1; const float* lk1; const float* lq2; const float* lk2; const float* subg;
    const float* dec_f; const float* dec_b; const float* w_upa; const float* w_upb; const float* w_o; const float* g_ffn; const float* w_gate; const float* w_up; const float* w_down; const float* g_final;
    float* out; unsigned char* ws;
};

__global__ void __launch_bounds__(NTHREADS, 2) hybrid_fwd(Args a) {
    extern __shared__ __attribute__((aligned(16))) unsigned char lds_raw[];
    cg::grid_group grid = cg::this_grid();
    const int tid = threadIdx.x, lane = tid & 63, wave = __builtin_amdgcn_readfirstlane(tid >> 6);
    const int G = gridDim.x, bx = blockIdx.x;
    const int vcu = (G % 8 == 0) ? (bx % 8) * (G / 8) + bx / 8 : bx;
    unsigned char* ws = a.ws;
    float* rowsq1 = (float*)(ws + WS_CTL); float* rowsq2 = rowsq1 + M;
    float* cosT = (float*)(ws + WS_ROPE); float* sinT = cosT + SEQ * 32;
    bf16_t* WinT = (bf16_t*)(ws + WS_WIN); bf16_t* WupT = (bf16_t*)(ws + WS_WUP); bf16_t* WoT = (bf16_t*)(ws + WS_WO); bf16_t* WguT = (bf16_t*)(ws + WS_WGU); bf16_t* WdT = (bf16_t*)(ws + WS_WD);
    bf16_t* Sst = (bf16_t*)(ws + WS_SST);
    bf16_t* Hb = (bf16_t*)(ws + WS_H); float* Ub = (float*)(ws + WS_H); bf16_t* AR = (bf16_t*)(ws + WS_H); bf16_t* X1B = (bf16_t*)(ws + WS_H);
    bf16_t* QKV = (bf16_t*)(ws + WS_QKV); bf16_t* Mb = (bf16_t*)(ws + WS_QKV); bf16_t* HM = (bf16_t*)(ws + WS_QKV);
    bf16_t* GATES = (bf16_t*)(ws + WS_GATES);
    PG8_LAS unsigned char* lds3 = (PG8_LAS unsigned char*)lds_raw;
    char* lds = (char*)lds_raw;
    volatile LAS unsigned* xst = (volatile LAS unsigned*)(lds3 + RING_BYTES);
    if (tid < 64) xst[tid] = 0u;
    __syncthreads();
    XcdBarrier bar = xcd_barrier_post((unsigned*)(ws + WS_CTL + BAR_OFF), xst);
    if (a.ws == nullptr) grid.sync();

    {
        float* scr = (float*)(lds + wave * 16384);
        const int gw = vcu * 8 + wave, NGW = G * 8;
        constexpr int I_IN = (DM / 64) * (NIN / 32), I_UP = (512 / 64) * (DM / 32), I_O = (DM / 64) * (DM / 32), I_G = (DM / 64) * (DFF / 32), I_D = (DFF / 64) * (DM / 32);
        constexpr int NITEMS = I_IN + 2 * I_UP + I_O + 2 * I_G + I_D;
        for (int it = gw; it < NITEMS; it += NGW) {
            int r = it;
            if (r < I_IN) { transpose_item(a.w_in, DM, NIN, WinT, 1, 0, nullptr, scr, r, lane); continue; } r -= I_IN;
            if (r < I_UP) { transpose_item(a.w_upa, 512, DM, WupT, 0, 0, nullptr, scr, r, lane); continue; } r -= I_UP;
            if (r < I_UP) { transpose_item(a.w_upb, 512, DM, WupT, 0, 1024, nullptr, scr, r, lane); continue; } r -= I_UP;
            if (r < I_O) { transpose_item(a.w_o, DM, DM, WoT, 0, 0, nullptr, scr, r, lane); continue; } r -= I_O;
            if (r < I_G) { transpose_item(a.w_gate, DM, DFF, WguT, 2, 0, a.g_ffn, scr, r, lane); continue; } r -= I_G;
            if (r < I_G) { transpose_item(a.w_up, DM, DFF, WguT, 3, 0, a.g_ffn, scr, r, lane); continue; } r -= I_G;
            transpose_item(a.w_down, DFF, DM, WdT, 0, 0, nullptr, scr, r, lane);
        }
        f32x4 gm[4];
#pragma unroll
        for (int j = 0; j < 4; ++j) gm[j] = ((const f32x4*)a.g_mix)[lane + 64 * j];
        for (int m = gw; m < M; m += NGW) {
            const f32x4* xr = (const f32x4*)(a.x + (size_t)m * DM) + lane; f32x4 v[4]; float s = 0.f;
#pragma unroll
            for (int j = 0; j < 4; ++j) { v[j] = xr[64 * j]; s += (v[j].x * v[j].x + v[j].y * v[j].y) + (v[j].z * v[j].z + v[j].w * v[j].w); }
            const float rstd = __builtin_amdgcn_rsqf(wave_sum(s) * (1.f / DM) + NORM_EPS);
            unsigned long long* o8 = (unsigned long long*)(Hb + (size_t)m * DM) + lane;
#pragma unroll
            for (int j = 0; j < 4; ++j) { const f32x4 w = v[j] * rstd * gm[j]; o8[64 * j] = (unsigned long long)pk2(w.x, w.y) | ((unsigned long long)pk2(w.z, w.w) << 32); }
        }
        for (int t = vcu * NTHREADS + tid; t < SEQ * 32; t += G * NTHREADS) {
            const int pos = t >> 5, i = t & 31;
            const float inv = (float)pow(10000.0, -(double)i / 32.0);
            const float ang = (float)pos * inv;
            const double rev = (double)ang * 0.15915494309189535; const float fr = (float)(rev - __builtin_rint(rev));
            cosT[t] = __builtin_amdgcn_cosf(fr); sinT[t] = __builtin_amdgcn_sinf(fr);
        }
    }
    xcd_barrier(bar);

    {
        pg8::Gemm g{Hb, WinT, M, NIN, DM}; pg8::StaticOrder S; S.init(M, NIN, G, bx);
        EpiProj E{QKV, GATES, cosT, sinT};
#ifndef NO_EPIPROJ
        for (int rep = 0; rep < DUP_P1; ++rep)
        pg8::gemm_phase<EpiProj, pg8::StaticOrder, true, true>(lds3, g, S, E);
#endif
    }
    xcd_barrier(bar);

    for (int rep = 0; rep < DUP_SYNC; ++rep) xcd_barrier(bar);
#ifndef NO_R1
    for (int u = vcu; u < 512 * DUP_R1; u += G) ret::r1_unit(u & 511, QKV, Ub, a.dec_f, a.dec_b, lds);
#endif
    xcd_barrier(bar);

    for (int idx = vcu * NTHREADS + tid; idx < 16 * 2 * 8192 * DUP_SCAN; idx += G * NTHREADS) {
        const int el = idx & 8191, dir = (idx >> 13) & 1, bh = (idx >> 14) & 15;
        const float lg = log2_sigmoid(dir ? a.dec_b[bh & 3] : a.dec_f[bh & 3]);
        const float Gc = __builtin_amdgcn_exp2f(128.f * lg);
        float S = 0.f;
#pragma unroll 8
        for (int st = 0; st < 32; ++st) { const int c = dir ? 31 - st : st; const size_t o = ((size_t)(bh * 32 + c) * 2 + dir) * 8192 + el;
            Sst[o] = f2bf(S); S = Gc * S + Ub[o]; }
    }
    xcd_barrier(bar);

    {
        float la = a.lq1[lane] * a.lk1[lane], lb = a.lq2[lane] * a.lk2[lane];
        la = wave_sum(la); lb = wave_sum(lb);
        const float lam = __expf(la) - __expf(lb) + 0.2f;
#ifndef NO_ATT
        for (int u = vcu; u < 512 * DUP_ATT; u += G) att::attn_unit((u >> 7) & 3, (u >> 5) & 3, u & 31, QKV, AR, a.subg, lam, lds);
#endif
#ifndef NO_R3
        for (int u = vcu; u < 512 * DUP_R3; u += G) ret::r3_unit(u & 511, QKV, Sst, AR + (size_t)M * 512, a.dec_f, a.dec_b, lds);
#endif
    }
    xcd_barrier(bar);

    {
        pg8::Gemm g{AR, WupT, 2 * M, 2048, 512}; PairOrder S; S.init(G, bx);
        EpiUp E{GATES, Mb};
#ifndef NO_EPIUP
        pg8::gemm_phase<EpiUp, PairOrder, true, true>(lds3, g, S, E);
#endif
    }
    xcd_barrier(bar);

    {
        pg8::Gemm g{Mb, WoT, M, DM, DM}; pg8::StaticOrder S; S.init(M, DM, G, bx);
        EpiRes E{a.x, a.out, X1B, rowsq1};
        pg8::gemm_phase<EpiRes, pg8::StaticOrder, true, true>(lds3, g, S, E);
    }
    xcd_barrier(bar);

    {
        pg8::Gemm g{X1B, WguT, M, NGU, DM}; pg8::StaticOrder S; S.init(M, NGU, G, bx);
        EpiSwiGLU E{rowsq1, HM};
#ifndef NO_EPISWIGLU
        for (int rep = 0; rep < DUP_P7; ++rep)
        pg8::gemm_phase<EpiSwiGLU, pg8::StaticOrder, true, true>(lds3, g, S, E);
#endif
    }
    xcd_barrier(bar);

    {
        pg8::Gemm g{HM, WdT, M, DM, DFF}; pg8::StaticOrder S; S.init(M, DM, G, bx);
        EpiRes E{a.out, a.out, nullptr, rowsq2};
        pg8::gemm_phase<EpiRes, pg8::StaticOrder, true, true>(lds3, g, S, E);
    }
    xcd_barrier(bar);

    {
        const int gw = vcu * 8 + wave, NGW = G * 8;
        f32x4 gf[4];
#pragma unroll
        for (int j = 0; j < 4; ++j) gf[j] = ((const f32x4*)a.g_final)[lane + 64 * j];
        for (int m = gw; m < M; m += NGW) {
            f32x4* xr = (f32x4*)(a.out + (size_t)m * DM) + lane;
            const float rstd = __builtin_amdgcn_rsqf(rowsq2[m] * (1.f / DM) + NORM_EPS);
#pragma unroll
            for (int j = 0; j < 4; ++j) xr[64 * j] = xr[64 * j] * rstd * gf[j];
        }
    }
}

extern "C" void kernel_launch(void* const* d_in, const int* in_sizes, int n_in, void* d_out, int out_size, void* d_ws, size_t ws_size, hipStream_t stream) {
    static int grid = 0;
    if (grid == 0) {
        if (n_in != 18 || in_sizes[0] != M * DM || out_size != M * DM || ws_size < WS_END) { fprintf(stderr, "kernel_launch: unexpected shapes (n_in %d, in0 %d, out %d, ws %zu)\n", n_in, n_in > 0 ? in_sizes[0] : -1, out_size, ws_size); grid = -1; return; }
        int dev = 0, cus = 0, per_cu = 0;
        if (hipGetDevice(&dev) != hipSuccess || hipDeviceGetAttribute(&cus, hipDeviceAttributeMultiprocessorCount, dev) != hipSuccess) { grid = -1; return; }
        if (hipFuncSetAttribute((const void*)hybrid_fwd, hipFuncAttributeMaxDynamicSharedMemorySize, LDS_BYTES) != hipSuccess) { fprintf(stderr, "kernel_launch: hipFuncSetAttribute failed\n"); grid = -1; return; }
        if (hipOccupancyMaxActiveBlocksPerMultiprocessor(&per_cu, (const void*)hybrid_fwd, NTHREADS, LDS_BYTES) != hipSuccess || per_cu < 1) { fprintf(stderr, "kernel_launch: occupancy query failed (%d)\n", per_cu); (void)hipGetLastError(); per_cu = 1; }
        if (per_cu > 1) per_cu = 1;
        grid = cus * per_cu;
    }
    if (grid < 0) return;
    (void)hipMemsetAsync((char*)d_ws + WS_CTL, 0, CTL_BYTES, stream);
    Args a{};
    a.x = (const float*)d_in[0]; a.g_mix = (const float*)d_in[1]; a.w_in = (const float*)d_in[2]; a.lq1 = (const float*)d_in[3]; a.lk1 = (const float*)d_in[4]; a.lq2 = (const float*)d_in[5]; a.lk2 = (const float*)d_in[6];
    a.subg = (const float*)d_in[7]; a.dec_f = (const float*)d_in[8]; a.dec_b = (const float*)d_in[9]; a.w_upa = (const float*)d_in[10]; a.w_upb = (const float*)d_in[11]; a.w_o = (const float*)d_in[12];
    a.g_ffn = (const float*)d_in[13]; a.w_gate = (const float*)d_in[14]; a.w_up = (const float*)d_in[15]; a.w_down = (const float*)d_in[16]; a.g_final = (const float*)d_in[17];
    a.out = (float*)d_out; a.ws = (unsigned char*)d_ws;
    void* args[] = {&a};
    const hipError_t e = hipLaunchCooperativeKernel((const void*)hybrid_fwd, dim3(grid), dim3(NTHREADS), args, LDS_BYTES, stream);
    if (e != hipSuccess) fprintf(stderr, "kernel_launch: cooperative launch failed: %s (grid %d)\n", hipGetErrorString(e), grid);
}
```
